# Optimizing an MI355X kernel written in HIP

```python
import math
import jax, jax.numpy as jnp
from jax import lax
import numpy as np

D_MODEL = 1024
BATCH = 8
SEQ = 2048
DEPTH = 4
DEC_BATCH = 128
DEC_SEQ = 4
PAST_LEN = 16384
PAGE_SIZE = 128

N_MIXERS = 3
N_A = len([i for i in range(DEPTH) if i % N_MIXERS == 0])
N_B = len([i for i in range(DEPTH) if i % N_MIXERS == 1])
N_C = len([i for i in range(DEPTH) if i % N_MIXERS == 2])

DN_ALPHA = (2.0 * DEPTH) ** 0.25
DN_BETA = (8.0 * DEPTH) ** -0.25
LN_EPS = 1e-5
CONV_W = 4

LRU_W = D_MODEL
LRU_BLOCKS = 16
LRU_BS = LRU_W // LRU_BLOCKS
LRU_C = 8.0

RW_W = D_MODEL
RW_N = 64
RW_H = RW_W // RW_N
RW_LORA_W = 64
RW_LORA_A = 64
RW_GN_EPS = 64e-5
RW_NORM_EPS = 1e-12

GDN_HK = 4
GDN_HV = 8
GDN_DK = 128
GDN_DV = 128
GDN_KEY_W = GDN_HK * GDN_DK
GDN_VAL_W = GDN_HV * GDN_DV
GDN_CONV_CH = 2 * GDN_KEY_W + GDN_VAL_W
GDN_IN_W = GDN_CONV_CH + GDN_VAL_W + 2 * GDN_HV
GDN_CHUNK = 64
GDN_EPS = 1e-6

kernel_name = 'hybrid_rglru_rwkv7_gdn_decode_step'


def layer_norm(x, g, b):
    xf = x.astype(jnp.float32)
    mu = jnp.mean(xf, -1, keepdims=True)
    var = jnp.mean(jnp.square(xf - mu), -1, keepdims=True)
    return ((xf - mu) * lax.rsqrt(var + LN_EPS) * g + b).astype(x.dtype)


def l2norm(z, eps):
    return z * lax.rsqrt(jnp.sum(z * z, -1, keepdims=True) + eps)


def causal_dwconv(x, buf, w, bias):
    T = x.shape[1]
    xp = jnp.concatenate([buf.astype(x.dtype), x], axis=1)
    y = xp[:, 0:T] * w[0]
    for j in range(1, CONV_W):
        y = y + xp[:, j:j + T] * w[j]
    if bias is not None:
        y = y + bias
    return y, xp[:, T:]


def _linear_combine(left, right):
    a1, b1 = left
    a2, b2 = right
    return a1 * a2, a2 * b1 + b2


def rglru_mixer(x, conv_buf, h0, w_in, conv_w, conv_b, wa, ba, wx, bx, lam, w_out):
    B, T, _ = x.shape
    f32 = jnp.float32
    u = x @ w_in
    xb, gate = u[..., :LRU_W], u[..., LRU_W:]
    xc, new_buf = causal_dwconv(xb, conv_buf, conv_w, conv_b)
    xh = xc.reshape(B, T, LRU_BLOCKS, LRU_BS)
    r = jax.nn.sigmoid((jnp.einsum('btni,nij->btnj', xh, wa).reshape(B, T, LRU_W) + ba).astype(f32))
    i = jax.nn.sigmoid((jnp.einsum('btni,nij->btnj', xh, wx).reshape(B, T, LRU_W) + bx).astype(f32))
    log_a = -LRU_C * r * jax.nn.softplus(-lam.astype(f32))
    a = jnp.exp(log_a)
    b = jnp.sqrt(-jnp.expm1(2.0 * log_a)) * i * xc.astype(f32)
    b = b.at[:, 0].add(a[:, 0] * h0.astype(f32))
    _, h = lax.associative_scan(_linear_combine, (a, b), axis=1)
    y = (h.astype(x.dtype) * jax.nn.silu(gate)) @ w_out
    return y, new_buf, h[:, -1]


def rwkv7_mixer(x, shift_buf, S0, mu, w_in, w0, w1, w2, a0, a1, a2, k_k, k_a, r_k, gn_g, gn_b, w_out):
    B, T, _ = x.shape
    f32 = jnp.float32
    x_prev = jnp.concatenate([shift_buf[:, None, :].astype(x.dtype), x[:, :-1]], axis=1)
    xx = x_prev - x
    xm = x[None] + xx[None] * mu[:, None, None, :]
    proj = jnp.einsum('nbtd,ndw->nbtw', xm[:4], w_in)
    r, k, v, gate = proj[0], proj[1], proj[2], proj[3]
    w_raw = (w0 + jnp.tanh(xm[4] @ w1) @ w2).astype(f32)
    log_w = -jnp.exp(-jax.nn.softplus(-w_raw) - 0.5)
    a = jax.nn.sigmoid((a0 + (xm[5] @ a1) @ a2).astype(f32))
    hd = lambda z: z.astype(f32).reshape(B, T, RW_H, RW_N)
    kk = l2norm(hd(k * k_k), RW_NORM_EPS)
    kh = hd(k.astype(f32) * (1.0 + (a - 1.0) * k_a))
    rh, vh, ah, wh = hd(r), hd(v), hd(a), jnp.exp(hd(log_w))

    def step(S, inp):
        r_t, w_t, k_t, v_t, a_t, b_t = inp
        sa = jnp.einsum('bhij,bhj->bhi', S, a_t)
        S = S * w_t[:, :, None, :] + sa[..., None] * b_t[:, :, None, :] + v_t[..., None] * k_t[:, :, None, :]
        return S, jnp.einsum('bhij,bhj->bhi', S, r_t)

    seq = tuple(jnp.moveaxis(z, 1, 0) for z in (rh, wh, kh, vh, -kk, kk * ah))
    S_T, ys = lax.scan(step, S0.astype(f32), seq)
    y = jnp.moveaxis(ys, 0, 1)
    m = jnp.mean(y, -1, keepdims=True)
    var = jnp.mean(jnp.square(y - m), -1, keepdims=True)
    yn = (y - m) * lax.rsqrt(var + RW_GN_EPS) * gn_g.reshape(RW_H, RW_N) + gn_b.reshape(RW_H, RW_N)
    bonus = jnp.sum(rh * kh * r_k.reshape(RW_H, RW_N), -1, keepdims=True) * vh
    o = (yn + bonus).reshape(B, T, RW_W).astype(x.dtype)
    return (o * jax.nn.silu(gate)) @ w_out, x[:, -1], S_T


def chunk_gated_delta(q, k, v, g, beta, S0):
    B, T, H, _ = q.shape
    C = min(GDN_CHUNK, T)
    n = -(-T // C)
    pad = n * C - T

    def blocks(z):
        z = jnp.pad(z, [(0, 0), (0, pad)] + [(0, 0)] * (z.ndim - 2))
        z = z.reshape((B, n, C) + z.shape[2:])
        return jnp.swapaxes(jnp.swapaxes(z, 2, 3), 0, 1)

    q, k, v, g, beta = blocks(q), blocks(k), blocks(v), blocks(g), blocks(beta)
    gc = jnp.cumsum(g, axis=-1)
    diff = gc[..., :, None] - gc[..., None, :]
    idx = jnp.arange(C)
    strict = idx[:, None] > idx[None, :]
    incl = idx[:, None] >= idx[None, :]
    kb = k * beta[..., None]
    L = jnp.where(strict, jnp.einsum('nbhid,nbhjd->nbhij', kb, k) * jnp.exp(jnp.where(strict, diff, 0.0)), 0.0)
    rhs = jnp.concatenate([v * beta[..., None], kb * jnp.exp(gc)[..., None]], axis=-1)
    sol = lax.linalg.triangular_solve(L, rhs, left_side=True, lower=True, unit_diagonal=True)
    U, Wd = sol[..., :GDN_DV], sol[..., GDN_DV:]
    A = jnp.where(incl, jnp.einsum('nbhid,nbhjd->nbhij', q, k) * jnp.exp(jnp.where(incl, diff, 0.0)), 0.0)
    qg = q * jnp.exp(gc)[..., None]
    kd = k * jnp.exp(gc[..., -1:] - gc)[..., None]
    g_last = jnp.exp(gc[..., -1])

    def step(S, inp):
        U_i, W_i, qg_i, kd_i, A_i, gl_i = inp
        v_new = U_i - jnp.einsum('bhck,bhkv->bhcv', W_i, S)
        o = jnp.einsum('bhck,bhkv->bhcv', qg_i, S) + jnp.einsum('bhij,bhjv->bhiv', A_i, v_new)
        S = S * gl_i[..., None, None] + jnp.einsum('bhck,bhcv->bhkv', kd_i, v_new)
        return S, o

    S_T, o = lax.scan(step, S0, (U, Wd, qg, kd, A, g_last))
    o = jnp.swapaxes(jnp.swapaxes(o, 0, 1), 2, 3).reshape(B, n * C, H, GDN_DV)[:, :T]
    return o, S_T


def gdn_mixer(x, conv_buf, S0, w_in, conv_w, a_log, dt_bias, norm_g, w_out):
    B, T, _ = x.shape
    f32 = jnp.float32
    u = x @ w_in
    o1 = GDN_CONV_CH
    o2 = o1 + GDN_VAL_W
    o3 = o2 + GDN_HV
    qkv, new_buf = causal_dwconv(u[..., :o1], conv_buf, conv_w, None)
    qkv = jax.nn.silu(qkv).astype(f32)
    q = qkv[..., :GDN_KEY_W].reshape(B, T, GDN_HK, GDN_DK)
    k = qkv[..., GDN_KEY_W:2 * GDN_KEY_W].reshape(B, T, GDN_HK, GDN_DK)
    v = qkv[..., 2 * GDN_KEY_W:].reshape(B, T, GDN_HV, GDN_DV)
    rep = GDN_HV // GDN_HK
    q = jnp.repeat(l2norm(q, GDN_EPS) * (GDN_DK ** -0.5), rep, axis=2)
    k = jnp.repeat(l2norm(k, GDN_EPS), rep, axis=2)
    beta = jax.nn.sigmoid(u[..., o2:o3].astype(f32))
    g = -jnp.exp(a_log.astype(f32)) * jax.nn.softplus(u[..., o3:].astype(f32) + dt_bias)
    o, S_T = chunk_gated_delta(q, k, v, g, beta, S0.astype(f32))
    o = o * lax.rsqrt(jnp.mean(o * o, -1, keepdims=True) + GDN_EPS) * norm_g
    z = u[..., o1:o2].astype(f32).reshape(B, T, GDN_HV, GDN_DV)
    o = (o * jax.nn.silu(z)).reshape(B, T, GDN_VAL_W).astype(x.dtype)
    return o @ w_out, new_buf, S_T


def trunk(x, st, w):
    (lru_conv, lru_h, rw_shift, rw_S, gdn_conv, gdn_S) = st
    (ln_g, ln_b, lru_w_in, lru_conv_w, lru_conv_b, lru_wa, lru_ba, lru_wx, lru_bx, lru_lambda, lru_w_out,
     rw_mu, rw_w_in, rw_w0, rw_w1, rw_w2, rw_a0, rw_a1, rw_a2, rw_k_k, rw_k_a, rw_r_k, rw_gn_g, rw_gn_b,
     rw_w_out, gdn_w_in, gdn_conv_w, gdn_a_log, gdn_dt_bias, gdn_norm_g, gdn_w_out) = w
    new = ([], [], [], [], [], [])
    ia = ib = ic = 0
    for layer in range(DEPTH):
        kind = layer % N_MIXERS
        if kind == 0:
            f, c, h = rglru_mixer(x, lru_conv[ia], lru_h[ia], lru_w_in[ia], lru_conv_w[ia], lru_conv_b[ia],
                                  lru_wa[ia], lru_ba[ia], lru_wx[ia], lru_bx[ia], lru_lambda[ia], lru_w_out[ia])
            new[0].append(c)
            new[1].append(h)
            ia += 1
        elif kind == 1:
            f, s, S = rwkv7_mixer(x, rw_shift[ib], rw_S[ib], rw_mu[ib], rw_w_in[ib], rw_w0[ib], rw_w1[ib],
                                  rw_w2[ib], rw_a0[ib], rw_a1[ib], rw_a2[ib], rw_k_k[ib], rw_k_a[ib],
                                  rw_r_k[ib], rw_gn_g[ib], rw_gn_b[ib], rw_w_out[ib])
            new[2].append(s)
            new[3].append(S)
            ib += 1
        else:
            f, c, S = gdn_mixer(x, gdn_conv[ic], gdn_S[ic], gdn_w_in[ic], gdn_conv_w[ic], gdn_a_log[ic],
                                gdn_dt_bias[ic], gdn_norm_g[ic], gdn_w_out[ic])
            new[4].append(c)
            new[5].append(S)
            ic += 1
        x = layer_norm(DN_ALPHA * x + f, ln_g[layer], ln_b[layer])
    dt = x.dtype
    return x, tuple(jnp.stack(s).astype(dt) for s in new)


def setup_inputs(seed: int = 0) -> dict:
    key = jax.random.key(seed)
    ks = iter(jax.random.split(key, 64))
    f32 = jnp.float32
    nrm = lambda shape, scale: jax.random.normal(next(ks), shape, f32) * scale
    uni = lambda shape, lo, hi: jax.random.uniform(next(ks), shape, f32, minval=lo, maxval=hi)
    D = D_MODEL
    d = {}
    d['x_prompt'] = nrm((BATCH, SEQ, D), 1.0)
    d['x_sample'] = nrm((DEC_BATCH, DEC_SEQ, D), 1.0)
    d['state_lru_conv'] = nrm((N_A, DEC_BATCH, CONV_W - 1, LRU_W), 1.0)
    d['state_lru_h'] = nrm((N_A, DEC_BATCH, LRU_W), 0.5)
    d['state_rwkv_shift'] = nrm((N_B, DEC_BATCH, D), 1.0)
    d['state_rwkv_wkv'] = nrm((N_B, DEC_BATCH, RW_H, RW_N, RW_N), 0.1)
    d['state_gdn_conv'] = nrm((N_C, DEC_BATCH, CONV_W - 1, GDN_CONV_CH), 1.0)
    d['state_gdn_S'] = nrm((N_C, DEC_BATCH, GDN_HV, GDN_DK, GDN_DV), 0.1)
    d['ln_g'] = 1.0 + nrm((DEPTH, D), 0.02)
    d['ln_b'] = nrm((DEPTH, D), 0.02)
    d['lru_w_in'] = nrm((N_A, D, 2 * LRU_W), D ** -0.5)
    d['lru_conv_w'] = nrm((N_A, CONV_W, LRU_W), CONV_W ** -0.5)
    d['lru_conv_b'] = nrm((N_A, LRU_W), 0.01)
    d['lru_wa'] = nrm((N_A, LRU_BLOCKS, LRU_BS, LRU_BS), LRU_BS ** -0.5)
    d['lru_ba'] = nrm((N_A, LRU_W), 0.01)
    d['lru_wx'] = nrm((N_A, LRU_BLOCKS, LRU_BS, LRU_BS), LRU_BS ** -0.5)
    d['lru_bx'] = nrm((N_A, LRU_W), 0.01)
    s = uni((N_A, LRU_W), 0.9, 0.999) ** (1.0 / LRU_C)
    d['lru_lambda'] = jnp.log(s) - jnp.log1p(-s)
    d['lru_w_out'] = nrm((N_A, LRU_W, D), LRU_W ** -0.5 * DN_BETA)
    d['rw_mu'] = uni((N_B, 6, D), 0.0, 1.0)
    d['rw_w_in'] = nrm((N_B, 4, D, RW_W), D ** -0.5)
    d['rw_w0'] = jnp.linspace(-6.0, -1.0, RW_W, dtype=f32)[None] + nrm((N_B, RW_W), 0.1)
    d['rw_w1'] = nrm((N_B, D, RW_LORA_W), D ** -0.5)
    d['rw_w2'] = nrm((N_B, RW_LORA_W, RW_W), 0.1 * RW_LORA_W ** -0.5)
    d['rw_a0'] = nrm((N_B, RW_W), 0.1)
    d['rw_a1'] = nrm((N_B, D, RW_LORA_A), D ** -0.5)
    d['rw_a2'] = nrm((N_B, RW_LORA_A, RW_W), RW_LORA_A ** -0.5)
    d['rw_k_k'] = 0.85 + nrm((N_B, RW_W), 0.02)
    d['rw_k_a'] = 1.0 + nrm((N_B, RW_W), 0.02)
    d['rw_r_k'] = nrm((N_B, RW_W), 0.1)
    d['rw_gn_g'] = 1.0 + nrm((N_B, RW_W), 0.02)
    d['rw_gn_b'] = nrm((N_B, RW_W), 0.02)
    d['rw_w_out'] = nrm((N_B, RW_W, D), RW_W ** -0.5 * DN_BETA)
    d['gdn_w_in'] = nrm((N_C, D, GDN_IN_W), D ** -0.5)
    d['gdn_conv_w'] = nrm((N_C, CONV_W, GDN_CONV_CH), CONV_W ** -0.5)
    d['gdn_a_log'] = jnp.log(uni((N_C, GDN_HV), 1.0, 16.0))
    dt = jnp.exp(uni((N_C, GDN_HV), math.log(1e-3), math.log(0.1)))
    d['gdn_dt_bias'] = dt + jnp.log(-jnp.expm1(-dt))
    d['gdn_norm_g'] = 1.0 + nrm((N_C, GDN_DV), 0.02)
    d['gdn_w_out'] = nrm((N_C, GDN_VAL_W, D), GDN_VAL_W ** -0.5 * DN_BETA)
    return d


def reference(x_prompt, x_sample, state_lru_conv, state_lru_h, state_rwkv_shift, state_rwkv_wkv,
              state_gdn_conv, state_gdn_S, ln_g, ln_b, lru_w_in, lru_conv_w, lru_conv_b, lru_wa, lru_ba,
              lru_wx, lru_bx, lru_lambda, lru_w_out, rw_mu, rw_w_in, rw_w0, rw_w1, rw_w2, rw_a0, rw_a1,
              rw_a2, rw_k_k, rw_k_a, rw_r_k, rw_gn_g, rw_gn_b, rw_w_out, gdn_w_in, gdn_conv_w, gdn_a_log,
              gdn_dt_bias, gdn_norm_g, gdn_w_out):
    w = (ln_g, ln_b, lru_w_in, lru_conv_w, lru_conv_b, lru_wa, lru_ba, lru_wx, lru_bx, lru_lambda, lru_w_out,
         rw_mu, rw_w_in, rw_w0, rw_w1, rw_w2, rw_a0, rw_a1, rw_a2, rw_k_k, rw_k_a, rw_r_k, rw_gn_g, rw_gn_b,
         rw_w_out, gdn_w_in, gdn_conv_w, gdn_a_log, gdn_dt_bias, gdn_norm_g, gdn_w_out)
    bp = x_prompt.shape[0]
    dt = x_prompt.dtype
    zero_state = (jnp.zeros((N_A, bp, CONV_W - 1, LRU_W), dt),
                  jnp.zeros((N_A, bp, LRU_W), dt),
                  jnp.zeros((N_B, bp, D_MODEL), dt),
                  jnp.zeros((N_B, bp, RW_H, RW_N, RW_N), dt),
                  jnp.zeros((N_C, bp, CONV_W - 1, GDN_CONV_CH), dt),
                  jnp.zeros((N_C, bp, GDN_HV, GDN_DK, GDN_DV), dt))
    y_prompt, sp = trunk(x_prompt, zero_state, w)
    y_sample, ss = trunk(x_sample, (state_lru_conv, state_lru_h, state_rwkv_shift, state_rwkv_wkv,
                                    state_gdn_conv, state_gdn_S), w)
    return (y_prompt, y_sample, sp[0], ss[0], sp[1], ss[1], sp[2], ss[2], sp[3], ss[3], sp[4], ss[4], sp[5], ss[5])
```

```cpp
#include <hip/hip_runtime.h>
#include <hip/hip_cooperative_groups.h>
#include <cstdio>
#include <cstring>
namespace cg = cooperative_groups;

typedef unsigned short bf16_t;
typedef __attribute__((ext_vector_type(8))) short bf16x8_t;
typedef __attribute__((ext_vector_type(16))) float f32x16;
typedef __attribute__((ext_vector_type(4))) unsigned u32x4;
typedef __attribute__((ext_vector_type(2))) unsigned u32x2;
typedef __attribute__((ext_vector_type(2))) float f32x2;
typedef __attribute__((ext_vector_type(4))) float f32x4v;
typedef __attribute__((ext_vector_type(4))) float f32x4;
__device__ __forceinline__ u32x4 mk_u4(unsigned a, unsigned b, unsigned c, unsigned d) { u32x4 r; r.x = a; r.y = b; r.z = c; r.w = d; return r; }

#define DM 1024
#define MP 16384
#define MS 512
#define MT 16896
#define NTHREADS 256

#define O_Y        0L
#define O_LRUCONVP 17301504L
#define O_LRUCONVS 17350656L
#define O_LRUHP    18137088L
#define O_LRUHS    18153472L
#define O_SHIFTP   18415616L
#define O_SHIFTS   18423808L
#define O_WKVP     18554880L
#define O_WKVS     19079168L
#define O_GCONVP   27467776L
#define O_GCONVS   27516928L
#define O_GSP      28303360L
#define O_GSS      29351936L

#define W_LRUWIN(l)  ((size_t)(l) * 2097152)
#define W_LRUWOUT(l) ((size_t)4194304 + (size_t)(l) * 1048576)
#define W_LRUWA(l)   ((size_t)6291456 + (size_t)(l) * 65536)
#define W_LRUWX(l)   ((size_t)6422528 + (size_t)(l) * 65536)
#define W_RWWIN      ((size_t)6553600)
#define W_RWW2T      ((size_t)11010048)
#define W_RWA2T      ((size_t)11075584)
#define W_RWWOUT     ((size_t)11141120)
#define W_GDNWIN     ((size_t)12189696)
#define W_GDNWOUT    ((size_t)15466496)
#define U_OFF     ((size_t)33554432)
#define R_OFF     ((size_t)180617216)
#define STATS_OFF ((size_t)249823232)
#define STATS_SZ  ((size_t)1081344)
#define SUMM_OFF  ((size_t)251985920)
#define BONUS_OFF ((size_t)254083072)

#define DN_ALPHA 1.681792830507429f

struct Params {
  const float* in[39];
  float* out;
  char* ws;
};

struct XSrc { const float* p0; const float* p1; const float* stats; const float* g; const float* b; };

__device__ __forceinline__ unsigned cvt_pk_bf16(float lo, float hi) {
  unsigned r;
  asm("v_cvt_pk_bf16_f32 %0, %1, %2" : "=v"(r) : "v"(lo), "v"(hi));
  return r;
}
__device__ __forceinline__ bf16_t f2bf(float f) { return (bf16_t)(cvt_pk_bf16(f, 0.f) & 0xffffu); }
__device__ __forceinline__ float bf2f(bf16_t h) { return __uint_as_float(((unsigned)h) << 16); }
__device__ __forceinline__ unsigned pack2(float lo, float hi) { return cvt_pk_bf16(lo, hi); }
__device__ __forceinline__ float bflo(unsigned w) { return __uint_as_float(w << 16); }
__device__ __forceinline__ float bfhi(unsigned w) { return __uint_as_float(w & 0xffff0000u); }
__device__ __forceinline__ float sigm(float x) { return __builtin_amdgcn_rcpf(1.f + __expf(-x)); }
__device__ __forceinline__ float ftanh(float x) { float e = __expf(2.f * x); return 1.f - 2.f * __builtin_amdgcn_rcpf(1.f + e); }
__device__ __forceinline__ float siluf(float x) { return x * sigm(x); }
__device__ __forceinline__ float softplusf(float x) { return fmaxf(x, 0.f) + log1pf(expf(-fabsf(x))); }

__device__ __forceinline__ int opaque_zero() { int z; asm volatile("s_mov_b32 %0, 0" : "=s"(z)); return z; }
template <int CTRL> __device__ __forceinline__ float dppf(float x) {
  return __builtin_bit_cast(float, __builtin_amdgcn_mov_dpp(__builtin_bit_cast(int, x), CTRL, 0xf, 0xf, true));
}
__device__ __forceinline__ float sum4(float x) { x += dppf<0xB1>(x); x += dppf<0x4E>(x); return x; }
__device__ __forceinline__ float sum8(float x) { x = sum4(x); x += dppf<0x141>(x); return x; }
__device__ __forceinline__ float sum16(float x) { x = sum8(x); x += dppf<0x140>(x); return x; }

__device__ __forceinline__ void unpack8(const u32x4 q, float* f) {
  f[0] = bflo(q.x); f[1] = bfhi(q.x); f[2] = bflo(q.y); f[3] = bfhi(q.y);
  f[4] = bflo(q.z); f[5] = bfhi(q.z); f[6] = bflo(q.w); f[7] = bfhi(q.w);
}

__device__ __forceinline__ void row_stats(const float* st, int row, float& mu, float& rstd) {
  const float4* p = (const float4*)(st + (size_t)row * 16);
  float4 a = p[0], b = p[1], c = p[2], d = p[3];
  float s = a.x + a.z + b.x + b.z + c.x + c.z + d.x + d.z;
  float q = a.y + a.w + b.y + b.w + c.y + c.w + d.y + d.w;
  mu = s * (1.f / 1024.f);
  float var = q * (1.f / 1024.f) - mu * mu;
  rstd = rsqrtf(fmaxf(var, 0.f) + 1e-5f);
}
__device__ __forceinline__ const float* xrow(const XSrc& xs, int row) {
  return row < MP ? xs.p0 + (size_t)row * DM : xs.p1 + (size_t)(row - MP) * DM;
}

__device__ __forceinline__ void convert_tile(const float* j_src, bf16_t* j_dst, int j_K, int j_Nsrc, int j_lds, int j_ldd,
                                             int j_sb, int j_db, int j_ntn, int lt, char* smem) {
  const int oz = opaque_zero();
  float* sT = (float*)smem;
  int nkt = j_K >> 6;
  int per_b = nkt * j_ntn;
  int bi = lt / per_b; int r = lt - bi * per_b;
  int kt = r / j_ntn; int nt = r - kt * j_ntn;
  const float* src = j_src + (size_t)bi * j_sb;
  bf16_t* dst = j_dst + (size_t)bi * j_db;
  int k0 = kt * 64, n0 = nt * 64;
  int tid = ((int)threadIdx.x + oz);
  int nn = tid & 63, kb = tid >> 6;
  int n = n0 + nn;
#pragma unroll
  for (int i = 0; i < 16; ++i) {
    int kk = kb + 4 * i;
    float v = (n < j_Nsrc) ? src[(size_t)(k0 + kk) * j_lds + n] : 0.f;
    sT[kk * 65 + nn] = v;
  }
  __syncthreads();
  int nr = tid >> 2, kq = (tid & 3) * 16;
  unsigned w[8];
#pragma unroll
  for (int e = 0; e < 8; ++e) w[e] = pack2(sT[(kq + 2 * e) * 65 + nr], sT[(kq + 2 * e + 1) * 65 + nr]);
  u32x4* d = (u32x4*)(dst + (size_t)(n0 + nr) * j_ldd + k0 + kq);
  d[0] = mk_u4(w[0], w[1], w[2], w[3]);
  d[1] = mk_u4(w[4], w[5], w[6], w[7]);
  __syncthreads();
}

#define NCONV_TILES 4032
__device__ __forceinline__ void phase_convert(const Params& p, char* smem) {
  const int oz = opaque_zero();
  bf16_t* WT = (bf16_t*)(p.ws + oz);
  for (int t = ((int)blockIdx.x + oz); t < NCONV_TILES; t += gridDim.x) {
    const float* j_src; bf16_t* j_dst; int j_K, j_Nsrc, j_lds, j_ldd, j_sb, j_db, j_ntn, j_t0;
#define JOBSET(SRC, DST, K_, NSRC, NDST, LDS_, LDD_, SB_, DB_, T0) { j_src = SRC; j_dst = DST; j_K = K_; j_Nsrc = NSRC; j_ntn = (NDST) / 64; j_lds = LDS_; j_ldd = LDD_; j_sb = SB_; j_db = DB_; j_t0 = T0; }
    if (t < 512)       JOBSET((p.in[10] + oz), WT + W_LRUWIN(0), 1024, 2048, 2048, 2048, 1024, 0, 0, 0)
    else if (t < 1024) JOBSET((p.in[10] + oz) + (size_t)1024 * 2048, WT + W_LRUWIN(1), 1024, 2048, 2048, 2048, 1024, 0, 0, 512)
    else if (t < 1280) JOBSET((p.in[18] + oz), WT + W_LRUWOUT(0), 1024, 1024, 1024, 1024, 1024, 0, 0, 1024)
    else if (t < 1536) JOBSET((p.in[18] + oz) + (size_t)1048576, WT + W_LRUWOUT(1), 1024, 1024, 1024, 1024, 1024, 0, 0, 1280)
    else if (t < 1552) JOBSET((p.in[13] + oz), WT + W_LRUWA(0), 64, 64, 64, 64, 64, 4096, 4096, 1536)
    else if (t < 1568) JOBSET((p.in[13] + oz) + 65536, WT + W_LRUWA(1), 64, 64, 64, 64, 64, 4096, 4096, 1552)
    else if (t < 1584) JOBSET((p.in[15] + oz), WT + W_LRUWX(0), 64, 64, 64, 64, 64, 4096, 4096, 1568)
    else if (t < 1600) JOBSET((p.in[15] + oz) + 65536, WT + W_LRUWX(1), 64, 64, 64, 64, 64, 4096, 4096, 1584)
    else if (t < 2624) JOBSET((p.in[20] + oz), WT + W_RWWIN, 1024, 1024, 1024, 1024, 1024, 1048576, 1048576, 1600)
    else if (t < 2656) JOBSET((p.in[22] + oz), WT + W_RWWIN + (size_t)4096 * 1024, 1024, 64, 128, 64, 1024, 0, 0, 2624)
    else if (t < 2688) JOBSET((p.in[25] + oz), WT + W_RWWIN + (size_t)4224 * 1024, 1024, 64, 128, 64, 1024, 0, 0, 2656)
    else if (t < 2704) JOBSET((p.in[23] + oz), WT + W_RWW2T, 64, 1024, 1024, 1024, 64, 0, 0, 2688)
    else if (t < 2720) JOBSET((p.in[26] + oz), WT + W_RWA2T, 64, 1024, 1024, 1024, 64, 0, 0, 2704)
    else if (t < 2976) JOBSET((p.in[32] + oz), WT + W_RWWOUT, 1024, 1024, 1024, 1024, 1024, 0, 0, 2720)
    else if (t < 3776) JOBSET((p.in[33] + oz), WT + W_GDNWIN, 1024, 3088, 3200, 3088, 1024, 0, 0, 2976)
    else               JOBSET((p.in[38] + oz), WT + W_GDNWOUT, 1024, 1024, 1024, 1024, 1024, 0, 0, 3776)
    convert_tile(j_src, j_dst, j_K, j_Nsrc, j_lds, j_ldd, j_sb, j_db, j_ntn, t - j_t0, smem);
  }
}

#define XS_OFF ((size_t)255164416)
__device__ __forceinline__ void phase_prepass(const Params& p, const XSrc xin, bool want_shift) {
  const int oz = opaque_zero();
  const int lane = ((int)threadIdx.x + oz) & 63;
  const int gw = ((int)blockIdx.x + oz) * 4 + (((int)threadIdx.x + oz) >> 6), nw = gridDim.x * 4;
  bf16_t* XA = (bf16_t*)((p.ws + oz) + R_OFF);
  const bool ln = xin.stats != nullptr;
  const int ch = lane * 16;
  for (int r4 = gw * 4; r4 < MT; r4 += nw * 4) {
    float4 a[4][4];
    float mu[4], rs[4];
#pragma unroll
    for (int r = 0; r < 4; ++r) {
      const float* z = xrow(xin, r4 + r);
#pragma unroll
      for (int q = 0; q < 4; ++q) a[r][q] = *(const float4*)(z + (q * 64 + lane) * 4);
      mu[r] = 0.f; rs[r] = 1.f;
      if (ln) row_stats(xin.stats, r4 + r, mu[r], rs[r]);
    }
#pragma unroll
    for (int q = 0; q < 4; ++q) {
      float4 gg = make_float4(1.f, 1.f, 1.f, 1.f), bb = make_float4(0.f, 0.f, 0.f, 0.f);
      if (ln) { gg = *(const float4*)(xin.g + (q * 64 + lane) * 4); bb = *(const float4*)(xin.b + (q * 64 + lane) * 4); }
#pragma unroll
      for (int r = 0; r < 4; ++r) {
        float4 v = a[r][q];
        if (ln) {
          v.x = (v.x - mu[r]) * rs[r] * gg.x + bb.x; v.y = (v.y - mu[r]) * rs[r] * gg.y + bb.y;
          v.z = (v.z - mu[r]) * rs[r] * gg.z + bb.z; v.w = (v.w - mu[r]) * rs[r] * gg.w + bb.w;
        }
        u32x2 w; w.x = pack2(v.x, v.y); w.y = pack2(v.z, v.w);
        *(u32x2*)(XA + (size_t)(r4 + r) * DM + (q * 64 + lane) * 4) = w;
      }
    }
  }
  if (want_shift) {
    bf16_t* XS = (bf16_t*)((p.ws + oz) + XS_OFF);
    const float* st = (p.in[4] + oz);
    for (int b = gw; b < 128; b += nw) {
      float v[16];
#pragma unroll
      for (int q = 0; q < 4; ++q) {
        float4 a = *(const float4*)(st + (size_t)b * DM + ch + q * 4);
        v[q * 4] = a.x; v[q * 4 + 1] = a.y; v[q * 4 + 2] = a.z; v[q * 4 + 3] = a.w;
      }
      *(u32x4*)(XS + (size_t)b * DM + ch) = mk_u4(pack2(v[0], v[1]), pack2(v[2], v[3]), pack2(v[4], v[5]), pack2(v[6], v[7]));
      *(u32x4*)(XS + (size_t)b * DM + ch + 8) = mk_u4(pack2(v[8], v[9]), pack2(v[10], v[11]), pack2(v[12], v[13]), pack2(v[14], v[15]));
    }
  }
}

#define GEMM_SWZ 1
#define GEMM_LDS_STAT 36864
template <int EPI, bool MIX>
__device__ __forceinline__ void gemm_phase(const bf16_t* Abf, int lda, const float* mixmu, const bf16_t* XS,
                           const bf16_t* Bt, int K, int NT,
                           bf16_t* C, int ldc,
                           const XSrc res, float* zout, float* statsOut,
                           char* smem) {
  const int oz = opaque_zero();
  bf16_t* As = (bf16_t*)smem;
  bf16_t* Bs = As + 128 * 72;
  float* sRS = (float*)(smem + GEMM_LDS_STAT);
  float* sMu = (float*)(smem + GEMM_LDS_STAT + 1024);
  const int tid = ((int)threadIdx.x + oz), lane = tid & 63, wave = tid >> 6;
  const int wm = wave >> 1, wn = wave & 1;
  const int lr = lane & 31, lh = lane >> 5;
  const int tiles = 132 * NT;
  const int tpx = (tiles + 7) >> 3;
  const int nk = K >> 6;
  int cur_mix = -1;

  for (int t = ((int)blockIdx.x + oz); t < 8 * tpx; t += gridDim.x) {
#if GEMM_SWZ
    int lt = (t & 7) * tpx + (t >> 3);
#else
    int lt = t;
#endif
    if (lt >= tiles) continue;
    int mt, nt;
    {
      const int pn = lt / (8 * NT), r = lt - pn * 8 * NT;
      const int hM = min(8, 132 - pn * 8);
      const int nsn = (NT + 7) >> 3;
      const int sn = min(r / (hM * 8), nsn - 1);
      const int r2 = r - sn * hM * 8;
      const int w = min(8, NT - sn * 8);
      const int mi = r2 / w;
      mt = pn * 8 + mi; nt = sn * 8 + (r2 - mi * w);
    }
    const int m0 = mt * 128, n0 = nt * 128;
    const bool isP = m0 < MP;

    if (EPI == 1) {
      if (tid < 128) {
        float mu = 0.f, rs = 1.f;
        if (res.stats != nullptr) row_stats(res.stats, m0 + tid, mu, rs);
        sRS[tid * 2] = mu; sRS[tid * 2 + 1] = rs;
      }
    }
    if (MIX) {
      const int mixn_ = nt < 32 ? (nt >> 3) : (nt == 32 ? 4 : 5);
      if (mixn_ != cur_mix) { *(float4*)(sMu + tid * 4) = *(const float4*)(mixmu + mixn_ * DM + tid * 4); cur_mix = mixn_; }
    }
    __syncthreads();

    f32x16 acc[2][2];
#pragma unroll
    for (int a = 0; a < 2; ++a)
#pragma unroll
      for (int b = 0; b < 2; ++b)
#pragma unroll
        for (int e = 0; e < 16; ++e) acc[a][b][e] = 0.f;

    struct Stage { u32x4 a[4]; u32x4 b[4]; u32x4 px; };
    Stage st0, st1;
    const int bc = tid & 7, brb = tid >> 3;
    int mixn = 0;
    if (MIX) mixn = nt < 32 ? (nt >> 3) : (nt == 32 ? 4 : 5);
    const bf16_t* aptr = Abf + (size_t)(m0 + brb * 4) * lda + bc * 8;
    const bf16_t* bptr = Bt + (size_t)(n0 + brb) * K + bc * 8;

    auto loadAB = [&](Stage& st, int kt) __attribute__((always_inline)) {
      const int k0 = kt * 64;
#pragma unroll
      for (int i = 0; i < 4; ++i) st.a[i] = *(const u32x4*)(aptr + (size_t)i * lda + k0);
#pragma unroll
      for (int i = 0; i < 4; ++i) st.b[i] = *(const u32x4*)(bptr + (size_t)(32 * i) * K + k0);
      if (MIX) {
        st.px = mk_u4(0, 0, 0, 0);
        const int row = m0 + brb * 4;
        if (isP) { if ((row & 2047) != 0) st.px = *(const u32x4*)(aptr - lda + k0); }
        else st.px = *(const u32x4*)(XS + (size_t)((row - MP) >> 2) * DM + k0 + bc * 8);
      }
    };
    auto storeAB = [&](Stage& st, int kt) __attribute__((always_inline)) {
      if (MIX) {
        float pv[8];
        unpack8(st.px, pv);
        const float4 mu0 = *(const float4*)(sMu + kt * 64 + bc * 8), mu1 = *(const float4*)(sMu + kt * 64 + bc * 8 + 4);
#pragma unroll
        for (int i = 0; i < 4; ++i) {
          float x[8];
          unpack8(st.a[i], x);
          u32x4 w;
          w.x = pack2(x[0] + (pv[0] - x[0]) * mu0.x, x[1] + (pv[1] - x[1]) * mu0.y);
          w.y = pack2(x[2] + (pv[2] - x[2]) * mu0.z, x[3] + (pv[3] - x[3]) * mu0.w);
          w.z = pack2(x[4] + (pv[4] - x[4]) * mu1.x, x[5] + (pv[5] - x[5]) * mu1.y);
          w.w = pack2(x[6] + (pv[6] - x[6]) * mu1.z, x[7] + (pv[7] - x[7]) * mu1.w);
          *(u32x4*)(As + (brb * 4 + i) * 72 + bc * 8) = w;
#pragma unroll
          for (int e = 0; e < 8; ++e) pv[e] = x[e];
        }
      } else {
#pragma unroll
        for (int i = 0; i < 4; ++i) *(u32x4*)(As + (brb * 4 + i) * 72 + bc * 8) = st.a[i];
      }
#pragma unroll
      for (int i = 0; i < 4; ++i) *(u32x4*)(Bs + (brb + 32 * i) * 72 + bc * 8) = st.b[i];
    };
    auto compute = [&]() __attribute__((always_inline)) {
      bf16x8_t af[4][2], bfr[4][2];
      const bf16_t* ap = As + (wm * 64 + lr) * 72 + lh * 8;
      const bf16_t* bp = Bs + (wn * 64 + lr) * 72 + lh * 8;
#define LDFRAG(ks) { af[ks][0] = *(const bf16x8_t*)(ap + ks * 16); af[ks][1] = *(const bf16x8_t*)(ap + 32 * 72 + ks * 16); \
                     bfr[ks][0] = *(const bf16x8_t*)(bp + ks * 16); bfr[ks][1] = *(const bf16x8_t*)(bp + 32 * 72 + ks * 16); }
#define MMA4(ks) { acc[0][0] = __builtin_amdgcn_mfma_f32_32x32x16_bf16(af[ks][0], bfr[ks][0], acc[0][0], 0, 0, 0); \
                   acc[0][1] = __builtin_amdgcn_mfma_f32_32x32x16_bf16(af[ks][0], bfr[ks][1], acc[0][1], 0, 0, 0); \
                   acc[1][0] = __builtin_amdgcn_mfma_f32_32x32x16_bf16(af[ks][1], bfr[ks][0], acc[1][0], 0, 0, 0); \
                   acc[1][1] = __builtin_amdgcn_mfma_f32_32x32x16_bf16(af[ks][1], bfr[ks][1], acc[1][1], 0, 0, 0); }
      LDFRAG(0) LDFRAG(1)
      __builtin_amdgcn_sched_barrier(0);
      MMA4(0)
      LDFRAG(2)
      __builtin_amdgcn_sched_barrier(0);
      MMA4(1)
      LDFRAG(3)
      __builtin_amdgcn_sched_barrier(0);
      MMA4(2)
      MMA4(3)
#undef LDFRAG
#undef MMA4
    };

    loadAB(st0, 0);
    loadAB(st1, 1);
#pragma unroll 1
    for (int kt = 0; kt < nk; kt += 2) {
      __syncthreads();
      storeAB(st0, kt);
      __syncthreads();
      if (kt + 2 < nk) loadAB(st0, kt + 2);
      compute();
      __syncthreads();
      storeAB(st1, kt + 1);
      __syncthreads();
      if (kt + 3 < nk) loadAB(st1, kt + 3);
      compute();
    }

    __syncthreads();
    if (EPI == 0) {
      bf16_t* sC = (bf16_t*)smem;
#pragma unroll
      for (int mi = 0; mi < 2; ++mi)
#pragma unroll
        for (int ni = 0; ni < 2; ++ni)
#pragma unroll
          for (int e = 0; e < 16; ++e) {
            int rl = wm * 64 + mi * 32 + (e & 3) + 8 * (e >> 2) + 4 * lh;
            int cl = wn * 64 + ni * 32 + lr;
            sC[rl * 136 + cl] = f2bf(acc[mi][ni][e]);
          }
      __syncthreads();
#pragma unroll
      for (int i = 0; i < 8; ++i) {
        int idx = tid + 256 * i;
        int rl = idx >> 4, ck = idx & 15;
        u32x4 v = *(const u32x4*)(sC + rl * 136 + ck * 8);
        *(u32x4*)(C + (size_t)(m0 + rl) * ldc + n0 + ck * 8) = v;
      }
      __syncthreads();
    } else {
      float* sC = (float*)smem;
      const bool ln = res.stats != nullptr;
      const float* rbase = isP ? res.p0 + (size_t)m0 * DM : res.p1 + (size_t)(m0 - MP) * DM;
      const int er = tid >> 2, ec = (tid & 3) * 32;
      float4 gq[8], bq[8];
#pragma unroll
      for (int q = 0; q < 8; ++q) {
        gq[q] = make_float4(1.f, 1.f, 1.f, 1.f); bq[q] = make_float4(0.f, 0.f, 0.f, 0.f);
        if (ln) { gq[q] = *(const float4*)(res.g + n0 + ec + q * 4); bq[q] = *(const float4*)(res.b + n0 + ec + q * 4); }
      }
#pragma unroll
      for (int mi = 0; mi < 2; ++mi) {
#pragma unroll
        for (int ni = 0; ni < 2; ++ni)
#pragma unroll
          for (int e = 0; e < 16; ++e) {
            int rl = wm * 32 + (e & 3) + 8 * (e >> 2) + 4 * lh;
            int cl = wn * 64 + ni * 32 + lr;
            sC[rl * 132 + cl] = acc[mi][ni][e];
          }
        __syncthreads();
        {
          const int rl = (er >> 5) * 64 + mi * 32 + (er & 31);
          float mu = 0.f, rs = 1.f;
          if (ln) { mu = sRS[rl * 2]; rs = sRS[rl * 2 + 1]; }
          float s_ = 0.f, q_ = 0.f;
          float4 xr[8];
#pragma unroll
          for (int q = 0; q < 8; ++q) xr[q] = *(const float4*)(rbase + (size_t)rl * DM + n0 + ec + q * 4);
#pragma unroll
          for (int q = 0; q < 8; ++q) {
            const int cl = ec + q * 4;
            float4 c4 = *(const float4*)(sC + er * 132 + cl);
            float4 x4 = xr[q];
            if (ln) {
              float4 gg = gq[q], bb = bq[q];
              x4.x = (x4.x - mu) * rs * gg.x + bb.x; x4.y = (x4.y - mu) * rs * gg.y + bb.y;
              x4.z = (x4.z - mu) * rs * gg.z + bb.z; x4.w = (x4.w - mu) * rs * gg.w + bb.w;
            }
            float4 z;
            z.x = DN_ALPHA * x4.x + c4.x; z.y = DN_ALPHA * x4.y + c4.y;
            z.z = DN_ALPHA * x4.z + c4.z; z.w = DN_ALPHA * x4.w + c4.w;
            *(float4*)(zout + (size_t)(m0 + rl) * DM + n0 + cl) = z;
            s_ += z.x + z.y + z.z + z.w;
            q_ += z.x * z.x + z.y * z.y + z.z * z.z + z.w * z.w;
          }
          s_ = sum4(s_); q_ = sum4(q_);
          if ((tid & 3) == 0) {
            statsOut[(size_t)(m0 + rl) * 16 + nt * 2] = s_;
            statsOut[(size_t)(m0 + rl) * 16 + nt * 2 + 1] = q_;
          }
        }
        __syncthreads();
      }
    }
  }
}

#define LA_OFF ((size_t)102760448)
#define LB_OFF ((size_t)137363456)
template <int MODE>
__device__ __forceinline__ void lru_tile(const Params& p, int la, int tt, int nb, char* smem) {
  const int oz = opaque_zero();
  float* sX = (float*)smem;
  float* sR = (float*)smem;
  float* sI = (float*)(smem + 17152);
  bf16_t* sA = (bf16_t*)(smem + 33536);
  bf16_t* sWa = (bf16_t*)(smem + 42752);
  bf16_t* sWx = (bf16_t*)(smem + 51968);
  float* sSeg = (float*)(smem + 61184);

  const int tid = ((int)threadIdx.x + oz), lane = tid & 63, wave = tid >> 6;
  const bf16_t* U = (const bf16_t*)((p.ws + oz) + U_OFF);
  const bf16_t* WT = (const bf16_t*)(p.ws + oz);
  const int r0 = tt * 64;
  const bool isP = r0 < MP;
  const int Tseq = isP ? 2048 : 4;
  const int ch0 = nb * 64;

  {
    int c8 = tid & 7;
#pragma unroll
    for (int i = 0; i < 3; ++i) {
      int mm = (tid >> 3) + 32 * i;
      if (mm < 67) {
        int row = r0 - 3 + mm;
        float f[8];
        if (row >= 0) {
          u32x4 q = *(const u32x4*)(U + (size_t)row * 2048 + ch0 + c8 * 8);
          unpack8(q, f);
        } else {
#pragma unroll
          for (int e = 0; e < 8; ++e) f[e] = 0.f;
        }
#pragma unroll
        for (int e = 0; e < 8; ++e) sX[mm * 64 + c8 * 8 + e] = f[e];
      }
    }
    const bf16_t* wa = WT + W_LRUWA(la) + (size_t)nb * 4096;
    const bf16_t* wx = WT + W_LRUWX(la) + (size_t)nb * 4096;
#pragma unroll
    for (int i = 0; i < 2; ++i) {
      int row = (tid >> 3) + 32 * i;
      *(u32x4*)(sWa + row * 72 + c8 * 8) = *(const u32x4*)(wa + row * 64 + c8 * 8);
      *(u32x4*)(sWx + row * 72 + c8 * 8) = *(const u32x4*)(wx + row * 64 + c8 * 8);
    }
  }
  __syncthreads();

  const int c = tid & 63, s = tid >> 6;
  const int gch = ch0 + c;
  float xc[16];
  {
    const float* cw = (p.in[11] + oz) + (size_t)la * 4096;
    float w0 = cw[gch], w1 = cw[1024 + gch], w2 = cw[2048 + gch], w3 = cw[3072 + gch];
    float cb = (p.in[12] + oz)[la * 1024 + gch];
    const float* cst = (p.in[2] + oz) + (size_t)la * 128 * 3 * 1024;
    float* oconv = (p.out + oz) + (isP ? O_LRUCONVP + (size_t)la * 8 * 3 * 1024 : O_LRUCONVS + (size_t)la * 128 * 3 * 1024);
#pragma unroll
    for (int i = 0; i < 16; ++i) {
      int m = s * 16 + i;
      int row = r0 + m;
      int t, b;
      if (isP) { t = row & 2047; b = row >> 11; } else { t = m & 3; b = (row - MP) >> 2; }
      float v0, v1, v2;
      float v3 = sX[(m + 3) * 64 + c];
      if (t >= 3) { v0 = sX[m * 64 + c]; v1 = sX[(m + 1) * 64 + c]; v2 = sX[(m + 2) * 64 + c]; }
      else {
        const float* bb = cst + (size_t)b * 3 * 1024 + gch;
        v0 = isP ? 0.f : bb[(size_t)t * 1024];
        v1 = (t + 1 >= 3) ? sX[(m + 1) * 64 + c] : (isP ? 0.f : bb[(size_t)(t + 1) * 1024]);
        v2 = (t + 2 >= 3) ? sX[(m + 2) * 64 + c] : (isP ? 0.f : bb[(size_t)(t + 2) * 1024]);
      }
      float v = cb + w0 * v0 + w1 * v1 + w2 * v2 + w3 * v3;
      xc[i] = v;
      sA[m * 72 + c] = f2bf(v);
      if (MODE == 1) {
        if (t >= Tseq - 3) oconv[((size_t)b * 3 + (t - (Tseq - 3))) * 1024 + gch] = v3;
      }
    }
  }
  __syncthreads();

  {
    const int wm = wave >> 1, wn = wave & 1, lr = lane & 31, lh = lane >> 5;
    f32x16 aR, aI;
#pragma unroll
    for (int e = 0; e < 16; ++e) { aR[e] = 0.f; aI[e] = 0.f; }
#pragma unroll
    for (int ks = 0; ks < 4; ++ks) {
      bf16x8_t af = *(const bf16x8_t*)(sA + (wm * 32 + lr) * 72 + ks * 16 + lh * 8);
      bf16x8_t b1 = *(const bf16x8_t*)(sWa + (wn * 32 + lr) * 72 + ks * 16 + lh * 8);
      bf16x8_t b2 = *(const bf16x8_t*)(sWx + (wn * 32 + lr) * 72 + ks * 16 + lh * 8);
      aR = __builtin_amdgcn_mfma_f32_32x32x16_bf16(af, b1, aR, 0, 0, 0);
      aI = __builtin_amdgcn_mfma_f32_32x32x16_bf16(af, b2, aI, 0, 0, 0);
    }
    int col = wn * 32 + lr;
    float ba = (p.in[14] + oz)[la * 1024 + ch0 + col], bx = (p.in[16] + oz)[la * 1024 + ch0 + col];
#pragma unroll
    for (int e = 0; e < 16; ++e) {
      int row = wm * 32 + (e & 3) + 8 * (e >> 2) + 4 * lh;
      sR[row * 64 + col] = sigm(aR[e] + ba);
      sI[row * 64 + col] = sigm(aI[e] + bx);
    }
  }
  __syncthreads();

  float av[16], bv[16];
  bf16_t* HL = (bf16_t*)((p.ws + oz) + LA_OFF);
  bf16_t* PC = (bf16_t*)((p.ws + oz) + LB_OFF);
  {
    float sp = softplusf(-(p.in[17] + oz)[la * 1024 + gch]);
#pragma unroll
    for (int i = 0; i < 16; ++i) {
      int m = s * 16 + i;
      float rr = sR[m * 64 + c], ii = sI[m * 64 + c];
      float a = __expf(-8.f * rr * sp);
      av[i] = a;
      bv[i] = __builtin_amdgcn_sqrtf(fmaxf(1.f - a * a, 0.f)) * ii * xc[i];
    }
  }
  if (isP) {
    float P = 1.f, H = 0.f;
#pragma unroll
    for (int i = 0; i < 16; ++i) { H = av[i] * H + bv[i]; P *= av[i]; }
    sSeg[(s * 64 + c) * 2] = P; sSeg[(s * 64 + c) * 2 + 1] = H;
    __syncthreads();
    float h = 0.f, pc = 1.f;
    for (int q = 0; q < s; ++q) {
      float Pq = sSeg[(q * 64 + c) * 2], Hq = sSeg[(q * 64 + c) * 2 + 1];
      h = Pq * h + Hq; pc *= Pq;
    }
#pragma unroll
    for (int i = 0; i < 16; ++i) {
      const size_t o = (size_t)(r0 + s * 16 + i) * 1024 + gch;
      h = av[i] * h + bv[i]; pc *= av[i];
      HL[o] = f2bf(h); PC[o] = f2bf(pc);
    }
    if (s == 3) {
      const int b = tt >> 5, ti = tt & 31;
      float* summ = (float*)((p.ws + oz) + SUMM_OFF);
      size_t o = (((size_t)b * 32 + ti) * 1024 + gch) * 2;
      summ[o] = pc; summ[o + 1] = h;
    }
  } else {
    const float* hst = (p.in[3] + oz) + (size_t)la * 128 * 1024;
    float h = 0.f;
#pragma unroll
    for (int i = 0; i < 16; ++i) {
      const int row = r0 + s * 16 + i;
      const int bs = (row - MP) >> 2;
      if ((i & 3) == 0) h = hst[(size_t)bs * 1024 + gch];
      h = av[i] * h + bv[i];
      HL[(size_t)row * 1024 + gch] = f2bf(h); PC[(size_t)row * 1024 + gch] = 0;
      if ((i & 3) == 3) (p.out + oz)[O_LRUHS + ((size_t)la * 128 + bs) * 1024 + gch] = h;
    }
  }
  __syncthreads();
}

__device__ __forceinline__ void phase_lru_carry(const Params& p, int la) {
  const int oz = opaque_zero();
  const float* summ = (const float*)((p.ws + oz) + SUMM_OFF);
  float* carry = (float*)((p.ws + oz) + BONUS_OFF);
  for (int g = ((int)blockIdx.x + oz) * NTHREADS + ((int)threadIdx.x + oz); g < 8192; g += gridDim.x * NTHREADS) {
    const int b = g >> 10, ch = g & 1023;
    float2 ph[32];
#pragma unroll
    for (int tp = 0; tp < 32; ++tp) ph[tp] = *(const float2*)(summ + (((size_t)b * 32 + tp) * 1024 + ch) * 2);
    float h = 0.f;
#pragma unroll
    for (int tp = 0; tp < 32; ++tp) { carry[((size_t)b * 32 + tp) * 1024 + ch] = h; h = ph[tp].x * h + ph[tp].y; }
    (p.out + oz)[O_LRUHP + ((size_t)la * 8 + b) * 1024 + ch] = h;
  }
}

__device__ __forceinline__ void phase_lru_light(const Params& p) {
  const int oz = opaque_zero();
  const int lane = ((int)threadIdx.x + oz) & 63;
  const int gw = ((int)blockIdx.x + oz) * 4 + (((int)threadIdx.x + oz) >> 6), nw = gridDim.x * 4;
  const bf16_t* U = (const bf16_t*)((p.ws + oz) + U_OFF);
  const bf16_t* HL = (const bf16_t*)((p.ws + oz) + LA_OFF);
  const bf16_t* PC = (const bf16_t*)((p.ws + oz) + LB_OFF);
  bf16_t* A2 = (bf16_t*)((p.ws + oz) + R_OFF);
  const float* carry = (const float*)((p.ws + oz) + BONUS_OFF);
  for (int r2 = gw * 2; r2 < MT; r2 += nw * 2) {
    const bool isP = r2 < MP;
    const float* cbase = carry + ((size_t)(r2 >> 11) * 32 + ((r2 >> 6) & 31)) * 1024;
    u32x2 hl[2][4], pc[2][4], gt[2][4];
    float4 cin[4];
#pragma unroll
    for (int q = 0; q < 4; ++q) {
      const int c4 = (q * 64 + lane) * 4;
      cin[q] = make_float4(0.f, 0.f, 0.f, 0.f);
      if (isP) cin[q] = *(const float4*)(cbase + c4);
#pragma unroll
      for (int r = 0; r < 2; ++r) {
        const size_t row = (size_t)(r2 + r);
        hl[r][q] = *(const u32x2*)(HL + row * 1024 + c4);
        pc[r][q] = *(const u32x2*)(PC + row * 1024 + c4);
        gt[r][q] = *(const u32x2*)(U + row * 2048 + 1024 + c4);
      }
    }
#pragma unroll
    for (int q = 0; q < 4; ++q) {
      const int c4 = (q * 64 + lane) * 4;
#pragma unroll
      for (int r = 0; r < 2; ++r) {
        float h0 = bflo(hl[r][q].x) + bflo(pc[r][q].x) * cin[q].x, h1 = bfhi(hl[r][q].x) + bfhi(pc[r][q].x) * cin[q].y;
        float h2 = bflo(hl[r][q].y) + bflo(pc[r][q].y) * cin[q].z, h3 = bfhi(hl[r][q].y) + bfhi(pc[r][q].y) * cin[q].w;
        u32x2 w;
        w.x = pack2(h0 * siluf(bflo(gt[r][q].x)), h1 * siluf(bfhi(gt[r][q].x)));
        w.y = pack2(h2 * siluf(bflo(gt[r][q].y)), h3 * siluf(bfhi(gt[r][q].y)));
        *(u32x2*)(A2 + (size_t)(r2 + r) * 1024 + c4) = w;
      }
    }
  }
}

__device__ __forceinline__ void phase_lru_heavy(const Params& p, int la, char* smem) {
  const int oz = opaque_zero();
  for (int it = ((int)blockIdx.x + oz); it < 264 * 16; it += gridDim.x) lru_tile<1>(p, la, it >> 4, it & 15, smem);
}

#define REP_GCH 1
#define RW_SQ 8
#define REP_RPRE 1
#define REP_GPRE 1
#define RW_LDU 4352
__device__ __forceinline__ void rwkv_item(const Params& p, int row0, int T, bool isP, int b, int h, int sp0, int sp1, char* smem) {
  const int oz = opaque_zero();
  float* sRr = (float*)smem;
  float* sK = (float*)(smem + 8192);
  float* sW = (float*)(smem + 16384);
  float* sAp = (float*)(smem + 24576);
  float* sBp = (float*)(smem + 32768);
  float* sV = (float*)(smem + 40960);
  bf16_t* sL1 = (bf16_t*)(smem + 43008);
  bf16_t* sL2 = (bf16_t*)(smem + 47616);

  const int tid = ((int)threadIdx.x + oz), lane = tid & 63, wave = tid >> 6;
  const bf16_t* U = (const bf16_t*)((p.ws + oz) + U_OFF);
  const bf16_t* WT = (const bf16_t*)(p.ws + oz);
  bf16_t* rawy = (bf16_t*)((p.ws + oz) + R_OFF);
  float* bonus = (float*)((p.ws + oz) + BONUS_OFF);
  const int lr = lane & 31, lh = lane >> 5;

  bf16x8_t wf[4];
  {
    const bf16_t* wsrc = WT + ((wave < 2) ? W_RWW2T : W_RWA2T) + (size_t)(h * 64 + (wave & 1) * 32 + lr) * 64;
#pragma unroll
    for (int ks = 0; ks < 4; ++ks) wf[ks] = *(const bf16x8_t*)(wsrc + ks * 16 + lh * 8);
  }

  const int tok = tid >> 3, c8 = (tid & 7) * 8;
  const int irow = tid >> 4, cg4 = (tid & 15) * 4;
  const int vstride = isP ? 16 : 64;
  float* sCst = (float*)(smem + 52224);
  float* sY = (float*)(smem + 53504);
  if (tid < 64) {
    sCst[tid] = (p.in[24] + oz)[h * 64 + tid]; sCst[64 + tid] = (p.in[21] + oz)[h * 64 + tid];
    sCst[128 + tid] = (p.in[27] + oz)[h * 64 + tid]; sCst[192 + tid] = (p.in[28] + oz)[h * 64 + tid];
    sCst[256 + tid] = (p.in[29] + oz)[h * 64 + tid];
  }

  u32x4 pr, pk, pl1, pl2, pv;
  auto prefetch = [&](int t0) __attribute__((always_inline)) {
    int t = t0 + tok;
    pr = mk_u4(0, 0, 0, 0); pk = pr; pl1 = pr; pl2 = pr; pv = pr;
    if (t < T) {
      const bf16_t* u = U + (size_t)(row0 + t) * RW_LDU;
      pr = *(const u32x4*)(u + h * 64 + c8);
      pk = *(const u32x4*)(u + 1024 + h * 64 + c8);
      pl1 = *(const u32x4*)(u + 4096 + c8);
      pl2 = *(const u32x4*)(u + 4224 + c8);
    }
    if (isP) {
      if (tid < 64) {
        int tv = t0 + (tid >> 1);
        if (tv < T) pv = *(const u32x4*)(U + (size_t)(row0 + tv) * RW_LDU + 2048 + h * 64 + sp0 * 16 + (tid & 1) * 8);
      }
    } else {
      if (tid < 32) {
        int tv = t0 + (tid >> 3);
        if (tv < T) pv = *(const u32x4*)(U + (size_t)(row0 + tv) * RW_LDU + 2048 + h * 64 + (tid & 7) * 8);
      }
    }
  };

  float S[4] = {0.f, 0.f, 0.f, 0.f};
  prefetch(0);
  for (int t0 = 0; t0 < T; t0 += 32) {
    const int ntok = min(32, T - t0);
    for (int prep = 0; prep < REP_RPRE; ++prep) {
    {
      float f[8];
      unpack8(pr, f);
#pragma unroll
      for (int e = 0; e < 8; ++e) sRr[tok * 64 + c8 + e] = f[e];
      unpack8(pk, f);
#pragma unroll
      for (int e = 0; e < 8; ++e) sK[tok * 64 + c8 + e] = f[e];
      unpack8(pl1, f);
      u32x4 q;
      q.x = pack2(ftanh(f[0]), ftanh(f[1])); q.y = pack2(ftanh(f[2]), ftanh(f[3]));
      q.z = pack2(ftanh(f[4]), ftanh(f[5])); q.w = pack2(ftanh(f[6]), ftanh(f[7]));
      *(u32x4*)(sL1 + tok * 72 + c8) = q;
      *(u32x4*)(sL2 + tok * 72 + c8) = pl2;
      unpack8(pv, f);
      if (isP) {
        if (tid < 64) {
#pragma unroll
          for (int e = 0; e < 8; ++e) sV[(tid >> 1) * 16 + (tid & 1) * 8 + e] = f[e];
        }
      } else {
        if (tid < 32) {
#pragma unroll
          for (int e = 0; e < 8; ++e) sV[(tid >> 3) * 64 + (tid & 7) * 8 + e] = f[e];
        }
      }
    }
    __syncthreads();
    {
      f32x16 a;
#pragma unroll
      for (int e = 0; e < 16; ++e) a[e] = 0.f;
      const bf16_t* sL = (wave < 2) ? sL1 : sL2;
#pragma unroll
      for (int ks = 0; ks < 4; ++ks) {
        bf16x8_t af = *(const bf16x8_t*)(sL + lr * 72 + ks * 16 + lh * 8);
        a = __builtin_amdgcn_mfma_f32_32x32x16_bf16(af, wf[ks], a, 0, 0, 0);
      }
      float* dstp = (wave < 2) ? sW : sBp;
      int col = (wave & 1) * 32 + lr;
#pragma unroll
      for (int e = 0; e < 16; ++e) {
        int trow = (e & 3) + 8 * (e >> 2) + 4 * lh;
        dstp[trow * 64 + col] = a[e];
      }
    }
    __syncthreads();
    {
      const int gc = h * 64 + c8;
      float kkv[8], av8[8], kh8[8];
      float ssq = 0.f, bon = 0.f;
#pragma unroll
      for (int e = 0; e < 8; ++e) {
        int ch = gc + e;
        float kraw = sK[tok * 64 + c8 + e];
        float rr = sRr[tok * 64 + c8 + e];
        float aval = sigm(sCst[c8 + e] + sBp[tok * 64 + c8 + e]);
        float wv = __expf(-0.6065306597126334f * sigm(sCst[64 + c8 + e] + sW[tok * 64 + c8 + e]));
        float kq = kraw * sCst[128 + c8 + e];
        ssq += kq * kq;
        float kh = kraw * (1.f + (aval - 1.f) * sCst[192 + c8 + e]);
        bon += rr * kh * sCst[256 + c8 + e];
        kkv[e] = kq; av8[e] = aval; kh8[e] = kh;
        sW[tok * 64 + c8 + e] = wv;
      }
      ssq = sum8(ssq); bon = sum8(bon);
      float inv = rsqrtf(ssq + 1e-12f);
#pragma unroll
      for (int e = 0; e < 8; ++e) {
        float kk = kkv[e] * inv;
        sAp[tok * 64 + c8 + e] = -kk;
        sBp[tok * 64 + c8 + e] = kk * av8[e];
        sK[tok * 64 + c8 + e] = kh8[e];
      }
      if (sp0 == 0 && (tid & 7) == 0 && tok < ntok) bonus[(size_t)(row0 + t0 + tok) * 16 + h] = bon;
    }
    __syncthreads();
    }
    if (t0 + 32 < T) prefetch(t0 + 32);
    for (int sp = sp0; sp < sp1; ++sp) {
      if (!isP) {
        float4 s0 = *(const float4*)((p.in[5] + oz) + (((size_t)b * 16 + h) * 64 + sp * 16 + irow) * 64 + cg4);
        S[0] = s0.x; S[1] = s0.y; S[2] = s0.z; S[3] = s0.w;
      }
      const int voff = isP ? irow : (sp * 16 + irow);
      f32x2 Sa, Sb;
      Sa.x = S[0]; Sa.y = S[1]; Sb.x = S[2]; Sb.y = S[3];
      for (int t = 0; t < ntok; ++t) {
        const f32x4 a4 = *(const f32x4*)(sAp + t * 64 + cg4);
        const f32x4 w4 = *(const f32x4*)(sW + t * 64 + cg4);
        const f32x4 b4 = *(const f32x4*)(sBp + t * 64 + cg4);
        const f32x4 k4 = *(const f32x4*)(sK + t * 64 + cg4);
        const f32x4 r4 = *(const f32x4*)(sRr + t * 64 + cg4);
        const float vv = sV[t * vstride + voff];
        f32x2 sav = Sa * a4.xy + Sb * a4.zw;
        const float sa = sum16(sav.x + sav.y);
        f32x2 sa2; sa2.x = sa; sa2.y = sa;
        f32x2 vv2; vv2.x = vv; vv2.y = vv;
        Sa = Sa * w4.xy + (sa2 * b4.xy + vv2 * k4.xy);
        Sb = Sb * w4.zw + (sa2 * b4.zw + vv2 * k4.zw);
        f32x2 yv = Sa * r4.xy + Sb * r4.zw;
        const float y = sum16(yv.x + yv.y);
        if ((tid & 15) == 0) rawy[(size_t)(row0 + t0 + t) * 1024 + h * 64 + sp * 16 + irow] = f2bf(y);
      }
      S[0] = Sa.x; S[1] = Sa.y; S[2] = Sb.x; S[3] = Sb.y;
      if (!isP) {
        *(float4*)((p.out + oz) + O_WKVS + (((size_t)b * 16 + h) * 64 + sp * 16 + irow) * 64 + cg4) = make_float4(S[0], S[1], S[2], S[3]);
      }
    }
    __syncthreads();
  }
  if (isP) {
    *(float4*)((p.out + oz) + O_WKVP + (((size_t)b * 16 + h) * 64 + sp0 * 16 + irow) * 64 + cg4) = make_float4(S[0], S[1], S[2], S[3]);
  }
}


#define RX_OFF (R_OFF + (size_t)34603008)
__device__ __forceinline__ void rwkv_pre_tile(const Params& p, int tile, char* smem) {
  const int oz = opaque_zero();
  float* sRr = (float*)smem;
  float* sK = (float*)(smem + 8192);
  float* sW = (float*)(smem + 16384);
  float* sBp = (float*)(smem + 24576);
  bf16_t* sL1 = (bf16_t*)(smem + 32768);
  bf16_t* sL2 = (bf16_t*)(smem + 37376);
  float* sCst = (float*)(smem + 41984);
  const int tid = ((int)threadIdx.x + oz), lane = tid & 63, wave = tid >> 6;
  bf16_t* U = (bf16_t*)((p.ws + oz) + U_OFF);
  const bf16_t* WT = (const bf16_t*)(p.ws + oz);
  bf16_t* X = (bf16_t*)((p.ws + oz) + RX_OFF);
  bf16_t* AP = (bf16_t*)((p.out + oz) + O_GSS);
  bf16_t* BP = AP + (size_t)MP * 1024;
  float* bonus = (float*)((p.ws + oz) + BONUS_OFF);
  const int lr = lane & 31, lh = lane >> 5;
  const int tok = tid >> 3, c8 = (tid & 7) * 8;
  const int row = tile * 32 + tok;
  bf16_t* u = U + (size_t)row * RW_LDU;
  {
    float f[8];
    unpack8(*(const u32x4*)(u + 4096 + c8), f);
    u32x4 q;
    q.x = pack2(ftanh(f[0]), ftanh(f[1])); q.y = pack2(ftanh(f[2]), ftanh(f[3]));
    q.z = pack2(ftanh(f[4]), ftanh(f[5])); q.w = pack2(ftanh(f[6]), ftanh(f[7]));
    *(u32x4*)(sL1 + tok * 72 + c8) = q;
    *(u32x4*)(sL2 + tok * 72 + c8) = *(const u32x4*)(u + 4224 + c8);
  }
  u32x4 pr, pk; bf16x8_t wf[4]; float cst[5] = {0.f, 0.f, 0.f, 0.f, 0.f};
  auto prefetch = [&](int h) __attribute__((always_inline)) {
    pr = *(const u32x4*)(u + h * 64 + c8);
    pk = *(const u32x4*)(u + 1024 + h * 64 + c8);
    const bf16_t* wsrc = WT + ((wave < 2) ? W_RWW2T : W_RWA2T) + (size_t)(h * 64 + (wave & 1) * 32 + lr) * 64;
#pragma unroll
    for (int ks = 0; ks < 4; ++ks) wf[ks] = *(const bf16x8_t*)(wsrc + ks * 16 + lh * 8);
    if (tid < 64) {
      cst[0] = (p.in[24] + oz)[h * 64 + tid]; cst[1] = (p.in[21] + oz)[h * 64 + tid]; cst[2] = (p.in[27] + oz)[h * 64 + tid];
      cst[3] = (p.in[28] + oz)[h * 64 + tid]; cst[4] = (p.in[29] + oz)[h * 64 + tid];
    }
  };
  prefetch(0);
  for (int h = 0; h < 16; ++h) {
    {
      float f[8];
      unpack8(pr, f);
#pragma unroll
      for (int e = 0; e < 8; ++e) sRr[tok * 64 + c8 + e] = f[e];
      unpack8(pk, f);
#pragma unroll
      for (int e = 0; e < 8; ++e) sK[tok * 64 + c8 + e] = f[e];
      if (tid < 64) {
#pragma unroll
        for (int q = 0; q < 5; ++q) sCst[q * 64 + tid] = cst[q];
      }
    }
    __syncthreads();
    {
      f32x16 a;
#pragma unroll
      for (int e = 0; e < 16; ++e) a[e] = 0.f;
      const bf16_t* sL = (wave < 2) ? sL1 : sL2;
#pragma unroll
      for (int ks = 0; ks < 4; ++ks) {
        bf16x8_t af = *(const bf16x8_t*)(sL + lr * 72 + ks * 16 + lh * 8);
        a = __builtin_amdgcn_mfma_f32_32x32x16_bf16(af, wf[ks], a, 0, 0, 0);
      }
      float* dstp = (wave < 2) ? sW : sBp;
      int col = (wave & 1) * 32 + lr;
#pragma unroll
      for (int e = 0; e < 16; ++e) dstp[((e & 3) + 8 * (e >> 2) + 4 * lh) * 64 + col] = a[e];
    }
    if (h + 1 < 16) prefetch(h + 1);
    __syncthreads();
    {
      float kkv[8], av8[8], kh8[8], xx[8];
      float ssq = 0.f, bon = 0.f;
#pragma unroll
      for (int e = 0; e < 8; ++e) {
        float kraw = sK[tok * 64 + c8 + e];
        float rr = sRr[tok * 64 + c8 + e];
        float aval = sigm(sCst[c8 + e] + sBp[tok * 64 + c8 + e]);
        xx[e] = 0.6065306597126334f * sigm(sCst[64 + c8 + e] + sW[tok * 64 + c8 + e]);
        float kq = kraw * sCst[128 + c8 + e];
        ssq += kq * kq;
        float kh = kraw * (1.f + (aval - 1.f) * sCst[192 + c8 + e]);
        bon += rr * kh * sCst[256 + c8 + e];
        kkv[e] = kq; av8[e] = aval; kh8[e] = kh;
      }
      ssq = sum8(ssq); bon = sum8(bon);
      float inv = rsqrtf(ssq + 1e-12f);
      float ap[8], bp[8];
#pragma unroll
      for (int e = 0; e < 8; ++e) { float kk = kkv[e] * inv; ap[e] = -kk; bp[e] = kk * av8[e]; }
      const size_t o = (size_t)row * 1024 + h * 64 + c8;
      *(u32x4*)(X + o) = mk_u4(pack2(xx[0], xx[1]), pack2(xx[2], xx[3]), pack2(xx[4], xx[5]), pack2(xx[6], xx[7]));
      *(u32x4*)(AP + o) = mk_u4(pack2(ap[0], ap[1]), pack2(ap[2], ap[3]), pack2(ap[4], ap[5]), pack2(ap[6], ap[7]));
      *(u32x4*)(BP + o) = mk_u4(pack2(bp[0], bp[1]), pack2(bp[2], bp[3]), pack2(bp[4], bp[5]), pack2(bp[6], bp[7]));
      *(u32x4*)(u + 1024 + h * 64 + c8) = mk_u4(pack2(kh8[0], kh8[1]), pack2(kh8[2], kh8[3]), pack2(kh8[4], kh8[5]), pack2(kh8[6], kh8[7]));
      if ((tid & 7) == 0) bonus[(size_t)row * 16 + h] = bon;
    }
    __syncthreads();
  }
}
__device__ __forceinline__ void phase_rwkv_pre(const Params& p, char* smem) {
  const int oz = opaque_zero();
  for (int it = ((int)blockIdx.x + oz); it < 512; it += gridDim.x) rwkv_pre_tile(p, it, smem);
}

__device__ __forceinline__ void rwkv_prompt_item(const Params& p, int b, int h, int half, char* smem) {
  const int oz = opaque_zero();
  float* sRr = (float*)smem;
  float* sK = (float*)(smem + 8192);
  float* sW = (float*)(smem + 16384);
  float* sAp = (float*)(smem + 24576);
  float* sBp = (float*)(smem + 32768);
  float* sV = (float*)(smem + 40960);
  float* sY = (float*)(smem + 45056);
  const int tid = ((int)threadIdx.x + oz);
  const bf16_t* U = (const bf16_t*)((p.ws + oz) + U_OFF);
  const bf16_t* X = (const bf16_t*)((p.ws + oz) + RX_OFF);
  const bf16_t* AP = (const bf16_t*)((p.out + oz) + O_GSS);
  const bf16_t* BP = AP + (size_t)MP * 1024;
  bf16_t* rawy = (bf16_t*)((p.ws + oz) + R_OFF);
  const int row0 = b * 2048;
  const int tok = tid >> 3, c8 = (tid & 7) * 8;
  const int irow = tid >> 3;
  u32x4 pr, pk, px, pa, pb, pv;
  auto prefetch = [&](int t0) __attribute__((always_inline)) {
    const size_t row = (size_t)(row0 + t0 + tok);
    pr = *(const u32x4*)(U + row * RW_LDU + h * 64 + c8);
    pk = *(const u32x4*)(U + row * RW_LDU + 1024 + h * 64 + c8);
    px = *(const u32x4*)(X + row * 1024 + h * 64 + c8);
    pa = *(const u32x4*)(AP + row * 1024 + h * 64 + c8);
    pb = *(const u32x4*)(BP + row * 1024 + h * 64 + c8);
    pv = *(const u32x4*)(U + (size_t)(row0 + t0 + ((tid & 127) >> 2)) * RW_LDU + 2048 + h * 64 + half * 32 + (tid & 3) * 8);
  };
  f32x2 S0, S1, S2, S3;
  S0.x = 0.f; S0.y = 0.f; S1 = S0; S2 = S0; S3 = S0;
  prefetch(0);
  for (int t0 = 0; t0 < 2048; t0 += 32) {
    {
      float f[8];
      unpack8(pr, f);
      *(float4*)(sRr + tok * 64 + c8) = make_float4(f[0], f[1], f[2], f[3]); *(float4*)(sRr + tok * 64 + c8 + 4) = make_float4(f[4], f[5], f[6], f[7]);
      unpack8(pk, f);
      *(float4*)(sK + tok * 64 + c8) = make_float4(f[0], f[1], f[2], f[3]); *(float4*)(sK + tok * 64 + c8 + 4) = make_float4(f[4], f[5], f[6], f[7]);
      unpack8(px, f);
      *(float4*)(sW + tok * 64 + c8) = make_float4(__expf(-f[0]), __expf(-f[1]), __expf(-f[2]), __expf(-f[3]));
      *(float4*)(sW + tok * 64 + c8 + 4) = make_float4(__expf(-f[4]), __expf(-f[5]), __expf(-f[6]), __expf(-f[7]));
      unpack8(pa, f);
      *(float4*)(sAp + tok * 64 + c8) = make_float4(f[0], f[1], f[2], f[3]); *(float4*)(sAp + tok * 64 + c8 + 4) = make_float4(f[4], f[5], f[6], f[7]);
      unpack8(pb, f);
      *(float4*)(sBp + tok * 64 + c8) = make_float4(f[0], f[1], f[2], f[3]); *(float4*)(sBp + tok * 64 + c8 + 4) = make_float4(f[4], f[5], f[6], f[7]);
      unpack8(pv, f);
      float* d = sV + ((tid & 127) >> 2) * 32 + (tid & 3) * 8;
      *(float4*)d = make_float4(f[0], f[1], f[2], f[3]); *(float4*)(d + 4) = make_float4(f[4], f[5], f[6], f[7]);
    }
    __syncthreads();
    if (t0 > 0) {
      const float* sYp = sY + (((t0 >> 5) + 1) & 1) * 1024;
      const int ty = tid >> 3, i4 = (tid & 7) * 4;
      u32x2 w; w.x = pack2(sYp[ty * 32 + i4], sYp[ty * 32 + i4 + 1]); w.y = pack2(sYp[ty * 32 + i4 + 2], sYp[ty * 32 + i4 + 3]);
      *(u32x2*)(rawy + (size_t)(row0 + t0 - 32 + ty) * 1024 + h * 64 + half * 32 + i4) = w;
    }
    if (t0 + 32 < 2048) prefetch(t0 + 32);
    float* sYc = sY + ((t0 >> 5) & 1) * 1024;
    f32x4 a0 = *(const f32x4*)(sAp + c8), a1 = *(const f32x4*)(sAp + c8 + 4);
    f32x4 w0 = *(const f32x4*)(sW + c8), w1 = *(const f32x4*)(sW + c8 + 4);
    f32x4 b0 = *(const f32x4*)(sBp + c8), b1 = *(const f32x4*)(sBp + c8 + 4);
    f32x4 k0 = *(const f32x4*)(sK + c8), k1 = *(const f32x4*)(sK + c8 + 4);
    f32x4 r0 = *(const f32x4*)(sRr + c8), r1 = *(const f32x4*)(sRr + c8 + 4);
    float vv = sV[irow];
#pragma unroll 2
    for (int t = 0; t < 32; ++t) {
      const int tn = (t + 1) & 31;
      const f32x4 na0 = *(const f32x4*)(sAp + tn * 64 + c8), na1 = *(const f32x4*)(sAp + tn * 64 + c8 + 4);
      const f32x4 nw0 = *(const f32x4*)(sW + tn * 64 + c8), nw1 = *(const f32x4*)(sW + tn * 64 + c8 + 4);
      const f32x4 nb0 = *(const f32x4*)(sBp + tn * 64 + c8), nb1 = *(const f32x4*)(sBp + tn * 64 + c8 + 4);
      const f32x4 nk0 = *(const f32x4*)(sK + tn * 64 + c8), nk1 = *(const f32x4*)(sK + tn * 64 + c8 + 4);
      const f32x4 nr0 = *(const f32x4*)(sRr + tn * 64 + c8), nr1 = *(const f32x4*)(sRr + tn * 64 + c8 + 4);
      const float nv = sV[tn * 32 + irow];
      f32x2 sav = (S0 * a0.xy + S1 * a0.zw) + (S2 * a1.xy + S3 * a1.zw);
      const float sa = sum8(sav.x + sav.y);
      f32x2 sa2; sa2.x = sa; sa2.y = sa;
      f32x2 vv2; vv2.x = vv; vv2.y = vv;
      S0 = S0 * w0.xy + (sa2 * b0.xy + vv2 * k0.xy);
      S1 = S1 * w0.zw + (sa2 * b0.zw + vv2 * k0.zw);
      S2 = S2 * w1.xy + (sa2 * b1.xy + vv2 * k1.xy);
      S3 = S3 * w1.zw + (sa2 * b1.zw + vv2 * k1.zw);
      f32x2 yv = (S0 * r0.xy + S1 * r0.zw) + (S2 * r1.xy + S3 * r1.zw);
      const float y = sum8(yv.x + yv.y);
      sYc[t * 32 + irow] = y;
      a0 = na0; a1 = na1; w0 = nw0; w1 = nw1; b0 = nb0; b1 = nb1; k0 = nk0; k1 = nk1; r0 = nr0; r1 = nr1; vv = nv;
    }
    __syncthreads();
  }
  {
    const float* sYp = sY + 1024;
    const int ty = tid >> 3, i4 = (tid & 7) * 4;
    u32x2 w; w.x = pack2(sYp[ty * 32 + i4], sYp[ty * 32 + i4 + 1]); w.y = pack2(sYp[ty * 32 + i4 + 2], sYp[ty * 32 + i4 + 3]);
    *(u32x2*)(rawy + (size_t)(row0 + 2048 - 32 + ty) * 1024 + h * 64 + half * 32 + i4) = w;
  }
  {
    float* so = (p.out + oz) + O_WKVP + (((size_t)b * 16 + h) * 64 + half * 32 + irow) * 64 + c8;
    *(float4*)so = make_float4(S0.x, S0.y, S1.x, S1.y);
    *(float4*)(so + 4) = make_float4(S2.x, S2.y, S3.x, S3.y);
  }
  __syncthreads();
}

__device__ __forceinline__ void phase_rwkv_scan(const Params& p, char* smem) {
  const int oz = opaque_zero();
  const int bid = ((int)blockIdx.x + oz), G = gridDim.x;
  const int xcd = bid & 7, local = bid >> 3;
  const bool even_ok = (G == 512);
  if (even_ok) {
    if (bid < 256) {
      const int it = bid;
      rwkv_prompt_item(p, it >> 5, (it >> 1) & 15, it & 1, smem);
      for (int j = RW_SQ * 256 + bid; j < 2048; j += 256) rwkv_item(p, MP + (j >> 4) * 4, 4, false, j >> 4, j & 15, 0, 4, smem);
    } else {
      const int sidx = bid - 256;
      for (int j = sidx; j < RW_SQ * 256; j += 256) rwkv_item(p, MP + (j >> 4) * 4, 4, false, j >> 4, j & 15, 0, 4, smem);
    }
  } else {
    for (int it = bid; it < 256 + 2048; it += G) {
      if (it < 256) rwkv_prompt_item(p, it >> 5, (it >> 1) & 15, it & 1, smem);
      else { const int j = it - 256; rwkv_item(p, MP + (j >> 4) * 4, 4, false, j >> 4, j & 15, 0, 4, smem); }
    }
  }
}

__device__ __forceinline__ void phase_rwkv_post(const Params& p, const XSrc x1) {
  const int oz = opaque_zero();
  const int lane = ((int)threadIdx.x + oz) & 63;
  const int gw = ((int)blockIdx.x + oz) * 4 + (((int)threadIdx.x + oz) >> 6), nw = gridDim.x * 4;
  bf16_t* U = (bf16_t*)((p.ws + oz) + U_OFF);
  const bf16_t* rawy = (const bf16_t*)((p.ws + oz) + R_OFF);
  const float* bonus = (const float*)((p.ws + oz) + BONUS_OFF);
  const int ch = lane * 16;
  float gng[16], gnb[16];
#pragma unroll
  for (int e = 0; e < 16; ++e) { gng[e] = (p.in[30] + oz)[ch + e]; gnb[e] = (p.in[31] + oz)[ch + e]; }
  for (int row = gw; row < MT; row += nw) {
    float y[16];
    unpack8(*(const u32x4*)(rawy + (size_t)row * 1024 + ch), y);
    unpack8(*(const u32x4*)(rawy + (size_t)row * 1024 + ch + 8), y + 8);
    float s = 0.f;
#pragma unroll
    for (int e = 0; e < 16; ++e) s += y[e];
    s = sum4(s);
    float m = s * (1.f / 64.f);
    float q2 = 0.f;
#pragma unroll
    for (int e = 0; e < 16; ++e) { float d = y[e] - m; q2 += d * d; }
    q2 = sum4(q2);
    float rs = rsqrtf(q2 * (1.f / 64.f) + 64e-5f);
    float bon = bonus[(size_t)row * 16 + (lane >> 2)];
    bf16_t* u = U + (size_t)row * RW_LDU;
    float vf[16], gf[16];
    unpack8(*(const u32x4*)(u + 2048 + ch), vf); unpack8(*(const u32x4*)(u + 2048 + ch + 8), vf + 8);
    unpack8(*(const u32x4*)(u + 3072 + ch), gf); unpack8(*(const u32x4*)(u + 3072 + ch + 8), gf + 8);
    unsigned w[8];
#pragma unroll
    for (int e = 0; e < 8; ++e) {
      float o0 = (y[2 * e] - m) * rs * gng[2 * e] + gnb[2 * e] + bon * vf[2 * e];
      float o1 = (y[2 * e + 1] - m) * rs * gng[2 * e + 1] + gnb[2 * e + 1] + bon * vf[2 * e + 1];
      w[e] = pack2(o0 * siluf(gf[2 * e]), o1 * siluf(gf[2 * e + 1]));
    }
    *(u32x4*)(u + ch) = mk_u4(w[0], w[1], w[2], w[3]);
    *(u32x4*)(u + ch + 8) = mk_u4(w[4], w[5], w[6], w[7]);
  }
  for (int sq = gw; sq < 136; sq += nw) {
    int row = sq < 8 ? sq * 2048 + 2047 : MP + (sq - 8) * 4 + 3;
    float mu, rs;
    row_stats(x1.stats, row, mu, rs);
    const float* z = xrow(x1, row);
    float* o = (p.out + oz) + (sq < 8 ? O_SHIFTP + (size_t)sq * 1024 : O_SHIFTS + (size_t)(sq - 8) * 1024);
#pragma unroll
    for (int e = 0; e < 16; ++e) o[ch + e] = (z[ch + e] - mu) * rs * x1.g[ch + e] + x1.b[ch + e];
  }
}

#define GD_LDU 3200
#define GQK_OFF ((size_t)141688832)
#define GVV_OFF (R_OFF + (size_t)34603008)
#define GSC_OFF SUMM_OFF
__device__ __forceinline__ void gdn_pre_tile(const Params& p, int tt) {
  const int oz = opaque_zero();
  const int tid = ((int)threadIdx.x + oz);
  const bf16_t* U = (const bf16_t*)((p.ws + oz) + U_OFF);
  bf16_t* QK = (bf16_t*)((p.ws + oz) + GQK_OFF);
  bf16_t* VV = (bf16_t*)((p.ws + oz) + GVV_OFF);
  float* SC = (float*)((p.ws + oz) + GSC_OFF);
  const int r0 = tt * 32;
  const bool isP = r0 < MP;
  const int Tseq = isP ? 2048 : 4;
  const int c8 = tid * 8;
  float cw[4][8];
#pragma unroll
  for (int j = 0; j < 4; ++j) {
    float4 a = *(const float4*)((p.in[34] + oz) + j * 2048 + c8), c = *(const float4*)((p.in[34] + oz) + j * 2048 + c8 + 4);
    cw[j][0] = a.x; cw[j][1] = a.y; cw[j][2] = a.z; cw[j][3] = a.w; cw[j][4] = c.x; cw[j][5] = c.y; cw[j][6] = c.z; cw[j][7] = c.w;
  }
  float w0[8], w1[8], w2[8];
#pragma unroll
  for (int e = 0; e < 8; ++e) { w0[e] = 0.f; w1[e] = 0.f; w2[e] = 0.f; }
  for (int mb = 0; mb < 32; mb += 16) {
    u32x4 rw[16];
#pragma unroll
    for (int i = 0; i < 16; ++i) rw[i] = *(const u32x4*)(U + (size_t)(r0 + mb + i) * GD_LDU + c8);
#pragma unroll
    for (int i = 0; i < 16; ++i) {
    const int m = mb + i;
    const int row = r0 + m;
    int t, b;
    if (isP) { t = row & 2047; b = row >> 11; } else { t = (row - MP) & 3; b = (row - MP) >> 2; }
    if (t == 0) {
      if (isP) {
#pragma unroll
        for (int e = 0; e < 8; ++e) { w0[e] = 0.f; w1[e] = 0.f; w2[e] = 0.f; }
      } else {
        const float* st = (p.in[6] + oz) + (size_t)b * 3 * 2048 + c8;
        float4 a, c;
        a = *(const float4*)(st); c = *(const float4*)(st + 4);
        w0[0] = a.x; w0[1] = a.y; w0[2] = a.z; w0[3] = a.w; w0[4] = c.x; w0[5] = c.y; w0[6] = c.z; w0[7] = c.w;
        a = *(const float4*)(st + 2048); c = *(const float4*)(st + 2048 + 4);
        w1[0] = a.x; w1[1] = a.y; w1[2] = a.z; w1[3] = a.w; w1[4] = c.x; w1[5] = c.y; w1[6] = c.z; w1[7] = c.w;
        a = *(const float4*)(st + 4096); c = *(const float4*)(st + 4096 + 4);
        w2[0] = a.x; w2[1] = a.y; w2[2] = a.z; w2[3] = a.w; w2[4] = c.x; w2[5] = c.y; w2[6] = c.z; w2[7] = c.w;
      }
    } else if (m == 0) {
      unpack8(*(const u32x4*)(U + (size_t)(row - 3) * GD_LDU + c8), w0);
      unpack8(*(const u32x4*)(U + (size_t)(row - 2) * GD_LDU + c8), w1);
      unpack8(*(const u32x4*)(U + (size_t)(row - 1) * GD_LDU + c8), w2);
    }
    float w3[8];
    unpack8(rw[i], w3);
    float x[8];
    float ssq = 0.f;
#pragma unroll
    for (int e = 0; e < 8; ++e) {
      float v = cw[0][e] * w0[e] + cw[1][e] * w1[e] + cw[2][e] * w2[e] + cw[3][e] * w3[e];
      v = siluf(v);
      x[e] = v; ssq += v * v;
    }
    if (t >= Tseq - 3) {
      float* o = (p.out + oz) + (isP ? O_GCONVP : O_GCONVS) + ((size_t)b * 3 + (t - (Tseq - 3))) * 2048 + c8;
      *(float4*)o = make_float4(w3[0], w3[1], w3[2], w3[3]);
      *(float4*)(o + 4) = make_float4(w3[4], w3[5], w3[6], w3[7]);
    }
    if (tid < 128) {
      ssq = sum16(ssq);
      float sc = rsqrtf(ssq + 1e-6f) * ((tid < 64) ? 0.08838834764831845f : 1.f);
      *(u32x4*)(QK + (size_t)row * 1024 + c8) = mk_u4(pack2(x[0] * sc, x[1] * sc), pack2(x[2] * sc, x[3] * sc), pack2(x[4] * sc, x[5] * sc), pack2(x[6] * sc, x[7] * sc));
    } else {
      *(u32x4*)(VV + (size_t)row * 1024 + (c8 - 1024)) = mk_u4(pack2(x[0], x[1]), pack2(x[2], x[3]), pack2(x[4], x[5]), pack2(x[6], x[7]));
    }
#pragma unroll
    for (int e = 0; e < 8; ++e) { w0[e] = w1[e]; w1[e] = w2[e]; w2[e] = w3[e]; }
    }
  }
  {
    const int m = tid >> 3, hv = tid & 7;
    const int row = r0 + m;
    float beta = sigm(bf2f(U[(size_t)row * GD_LDU + 3072 + hv]));
    float g = -expf((p.in[35] + oz)[hv]) * softplusf(bf2f(U[(size_t)row * GD_LDU + 3080 + hv]) + (p.in[36] + oz)[hv]);
    SC[(size_t)row * 32 + hv] = expf(g);
    SC[(size_t)row * 32 + 8 + hv] = beta;
    __shared__ float sGp[32 * 8];
    sGp[m * 8 + hv] = g;
    __syncthreads();
    float gc = 0.f;
    const int mb = m & 16;
#pragma unroll
    for (int j = 0; j < 16; ++j) gc += (mb + j <= m) ? sGp[(mb + j) * 8 + hv] : 0.f;
    SC[(size_t)row * 32 + 16 + hv] = gc;
    __syncthreads();
  }
}
__device__ __forceinline__ void phase_gdn_pre(const Params& p) {
  const int oz = opaque_zero();
  for (int it = ((int)blockIdx.x + oz); it < 528; it += gridDim.x) gdn_pre_tile(p, it);
}

__device__ __forceinline__ void gdn_item(const Params& p, int row0, int T, bool isP, int b, int hv, int sl0, int sl1, char* smem) {
  const int oz = opaque_zero();
  float* sQ = (float*)smem;
  float* sKk = (float*)(smem + 16384);
  float* sV = (float*)(smem + 32768);
  float* sSc = (float*)(smem + 34816);

  const int tid = ((int)threadIdx.x + oz);
  const bf16_t* QK = (const bf16_t*)((p.ws + oz) + GQK_OFF);
  const bf16_t* VV = (const bf16_t*)((p.ws + oz) + GVV_OFF);
  const float* SC = (const float*)((p.ws + oz) + GSC_OFF);
  bf16_t* rawo = (bf16_t*)((p.ws + oz) + R_OFF);
  const int hk = hv >> 1;
  const int vcols = isP ? 16 : 128;

  const int col = tid >> 4, kg8 = (tid & 15) * 8;
  float S[8];
#pragma unroll
  for (int e = 0; e < 8; ++e) S[e] = 0.f;

  u32x4 pq[2], pk[2], pvv; float pe = 0.f, pb = 0.f;
  auto prefetch = [&](int t0) __attribute__((always_inline)) {
#pragma unroll
    for (int i = 0; i < 2; ++i) {
      int idx = tid + 256 * i;
      int tok = idx >> 4, cc = (idx & 15) * 8;
      pq[i] = mk_u4(0, 0, 0, 0); pk[i] = pq[i];
      if (t0 + tok < T) {
        pq[i] = *(const u32x4*)(QK + (size_t)(row0 + t0 + tok) * 1024 + hk * 128 + cc);
        pk[i] = *(const u32x4*)(QK + (size_t)(row0 + t0 + tok) * 1024 + 512 + hk * 128 + cc);
      }
    }
    pvv = mk_u4(0, 0, 0, 0);
    if (tid < 64) {
      if (isP) { int tok = tid >> 1; if (t0 + tok < T) pvv = *(const u32x4*)(VV + (size_t)(row0 + t0 + tok) * 1024 + hv * 128 + sl0 * 16 + (tid & 1) * 8); }
      else { int tok = tid >> 4; if (t0 + tok < T) pvv = *(const u32x4*)(VV + (size_t)(row0 + t0 + tok) * 1024 + hv * 128 + (tid & 15) * 8); }
    }
    if (tid < 32) {
      pe = 1.f; pb = 0.f;
      if (t0 + tid < T) { pe = SC[(size_t)(row0 + t0 + tid) * 32 + hv]; pb = SC[(size_t)(row0 + t0 + tid) * 32 + 8 + hv]; }
    }
  };

  prefetch(0);
  for (int t0 = 0; t0 < T; t0 += 32) {
    const int ntok = min(32, T - t0);
#pragma unroll
    for (int i = 0; i < 2; ++i) {
      int idx = tid + 256 * i;
      int tok = idx >> 4, cc = (idx & 15) * 8;
      float f[8];
      unpack8(pq[i], f);
      *(float4*)(sQ + tok * 128 + cc) = make_float4(f[0], f[1], f[2], f[3]);
      *(float4*)(sQ + tok * 128 + cc + 4) = make_float4(f[4], f[5], f[6], f[7]);
      unpack8(pk[i], f);
      *(float4*)(sKk + tok * 128 + cc) = make_float4(f[0], f[1], f[2], f[3]);
      *(float4*)(sKk + tok * 128 + cc + 4) = make_float4(f[4], f[5], f[6], f[7]);
    }
    if (tid < 64) {
      float f[8];
      unpack8(pvv, f);
      float* d = isP ? (sV + (tid >> 1) * 16 + (tid & 1) * 8) : (sV + (tid >> 4) * 128 + (tid & 15) * 8);
      *(float4*)d = make_float4(f[0], f[1], f[2], f[3]);
      *(float4*)(d + 4) = make_float4(f[4], f[5], f[6], f[7]);
    }
    if (tid < 32) { sSc[tid * 4] = pe; sSc[tid * 4 + 1] = pb; }
    __syncthreads();
    {
      const int tok = tid >> 3, part = tid & 7;
      float d = 0.f;
#pragma unroll
      for (int e = 0; e < 16; ++e) d += sQ[tok * 128 + part * 16 + e] * sKk[tok * 128 + part * 16 + e];
      d = sum8(d);
      if (part == 0) sSc[tok * 4 + 2] = d;
    }
    __syncthreads();
    if (t0 + 32 < T) prefetch(t0 + 32);
    for (int sl = sl0; sl < sl1; ++sl) {
      const int vc = isP ? col : (sl * 16 + col);
      const size_t sbase = (((size_t)b * 8 + hv) * 128 + kg8) * 128 + sl * 16 + col;
      float* sS = (float*)(smem + 35328);
      if (!isP) {
        const size_t gb = (((size_t)b * 8 + hv) * 128) * 128 + sl * 16;
#pragma unroll
        for (int i = 0; i < 2; ++i) {
          int k = (tid >> 2) + 64 * i, c4 = (tid & 3) * 4;
          *(float4*)(sS + k * 16 + c4) = *(const float4*)((p.in[7] + oz) + gb + (size_t)k * 128 + c4);
        }
        __syncthreads();
#pragma unroll
        for (int e = 0; e < 8; ++e) S[e] = sS[(kg8 + e) * 16 + col];
      }
      f32x2 S2[4];
#pragma unroll
      for (int e = 0; e < 4; ++e) { S2[e].x = S[2 * e]; S2[e].y = S[2 * e + 1]; }
      for (int t = 0; t < ntok; ++t) {
        const f32x4 k0 = *(const f32x4*)(sKk + t * 128 + kg8), k1 = *(const f32x4*)(sKk + t * 128 + kg8 + 4);
        const f32x4 q0 = *(const f32x4*)(sQ + t * 128 + kg8), q1 = *(const f32x4*)(sQ + t * 128 + kg8 + 4);
        const f32x4 sc = *(const f32x4*)(sSc + t * 4);
        const float vv = sV[t * vcols + vc];
        const f32x2 ka = k0.xy, kb = k0.zw, kc = k1.xy, kd = k1.zw;
        const f32x2 qa = q0.xy, qb = q0.zw, qc = q1.xy, qd = q1.zw;
        f32x2 d1v = (S2[0] * ka + S2[1] * kb) + (S2[2] * kc + S2[3] * kd);
        f32x2 d2v = (S2[0] * qa + S2[1] * qb) + (S2[2] * qc + S2[3] * qd);
        float d1 = sum16(d1v.x + d1v.y);
        float d2 = sum16(d2v.x + d2v.y);
        const float eg = sc.x;
        const float vnew = sc.y * (vv - eg * d1);
        f32x2 eg2; eg2.x = eg; eg2.y = eg;
        f32x2 vn2; vn2.x = vnew; vn2.y = vnew;
        S2[0] = S2[0] * eg2 + ka * vn2; S2[1] = S2[1] * eg2 + kb * vn2;
        S2[2] = S2[2] * eg2 + kc * vn2; S2[3] = S2[3] * eg2 + kd * vn2;
        float o = eg * d2 + sc.z * vnew;
        if ((tid & 15) == 0) rawo[(size_t)(row0 + t0 + t) * 1024 + hv * 128 + sl * 16 + col] = f2bf(o);
      }
#pragma unroll
      for (int e = 0; e < 4; ++e) { S[2 * e] = S2[e].x; S[2 * e + 1] = S2[e].y; }
      if (!isP) {
        const size_t gb = (((size_t)b * 8 + hv) * 128) * 128 + sl * 16;
        __syncthreads();
#pragma unroll
        for (int e = 0; e < 8; ++e) sS[(kg8 + e) * 16 + col] = S[e];
        __syncthreads();
#pragma unroll
        for (int i = 0; i < 2; ++i) {
          int k = (tid >> 2) + 64 * i, c4 = (tid & 3) * 4;
          *(float4*)((p.out + oz) + O_GSS + gb + (size_t)k * 128 + c4) = *(const float4*)(sS + k * 16 + c4);
        }
        __syncthreads();
      }
    }
    __syncthreads();
  }
  if (isP) {
    const size_t sbase = (((size_t)b * 8 + hv) * 128 + kg8) * 128 + sl0 * 16 + col;
#pragma unroll
    for (int e = 0; e < 8; ++e) (p.out + oz)[O_GSP + sbase + (size_t)e * 128] = S[e];
  }
  __syncthreads();
}

__device__ __forceinline__ void gdn_chunk_item(const Params& p, int b, int hv, int sl4, char* smem) {
  const int oz = opaque_zero();
  bf16_t* sKb = (bf16_t*)smem;
  bf16_t* sQb = (bf16_t*)(smem + 4352);
  bf16_t* sKT = (bf16_t*)(smem + 8704);
  bf16_t* sSb = (bf16_t*)(smem + 18944);
  bf16_t* sVn = (bf16_t*)(smem + 27648);
  float* sKK = (float*)(smem + 30208);
  float* sQK = (float*)(smem + 31296);
  float* sKS = (float*)(smem + 32384);
  float* sQS = (float*)(smem + 34496);
  float* sL = (float*)(smem + 36608);
  float* sA = (float*)(smem + 37888);
  float* sVf = (float*)(smem + 38976);
  float* sG = (float*)(smem + 41024);
  float* sVnF = (float*)(smem + 41280);
  float* sG0 = (float*)(smem + 43392);

  const int tid = ((int)threadIdx.x + oz), lane = tid & 63, wave = tid >> 6;
  const bf16_t* QK = (const bf16_t*)((p.ws + oz) + GQK_OFF);
  const bf16_t* VV = (const bf16_t*)((p.ws + oz) + GVV_OFF);
  const float* SC = (const float*)((p.ws + oz) + GSC_OFF);
  bf16_t* rawo = (bf16_t*)((p.ws + oz) + R_OFF);
  const int hk = hv >> 1;
  const int row0 = b * 2048;
  const int ln = lane & 15, lg = lane >> 4;
  const int tok = tid >> 4, cc = (tid & 15) * 8;
  const int vtok = (tid & 63) >> 2, vpart = (tid & 3) * 8;
  const size_t ocol = (size_t)hv * 128 + sl4 * 32;

  for (int i = tid; i < 128 * 40; i += NTHREADS) sKT[i] = 0;
  for (int i = tid; i < 32 * 40; i += NTHREADS) sVn[i] = 0;

  f32x4v St[2][2];
#pragma unroll
  for (int e = 0; e < 4; ++e) { St[0][0][e] = 0.f; St[0][1][e] = 0.f; St[1][0][e] = 0.f; St[1][1][e] = 0.f; }

  struct PF { u32x4 pK, pQ, pV; float pg, pb; };
  PF R0, R1;
  auto prefetch = [&](PF& R, int t0) __attribute__((always_inline)) {
    const size_t r = (size_t)(row0 + t0 + tok) * 1024;
    R.pQ = *(const u32x4*)(QK + r + hk * 128 + cc);
    R.pK = *(const u32x4*)(QK + r + 512 + hk * 128 + cc);
    R.pV = *(const u32x4*)(VV + (size_t)(row0 + t0 + vtok) * 1024 + ocol + vpart);
    R.pg = SC[(size_t)(row0 + t0 + (tid & 15)) * 32 + 16 + hv]; R.pb = SC[(size_t)(row0 + t0 + (tid & 15)) * 32 + 8 + hv];
  };
  prefetch(R0, 0);
  prefetch(R1, 16);
  __syncthreads();
  float o_prev0 = 0.f, o_prev1 = 0.f;
  auto chunk_body = [&](PF& R, int t0) __attribute__((always_inline)) {
    *(u32x4*)(sKb + tok * 136 + cc) = R.pK;
    *(u32x4*)(sQb + tok * 136 + cc) = R.pQ;
    {
      float f[8];
      unpack8(R.pV, f);
      float* d = sVf + vtok * 32 + vpart;
      *(float4*)d = make_float4(f[0], f[1], f[2], f[3]); *(float4*)(d + 4) = make_float4(f[4], f[5], f[6], f[7]);
    }
    if (tid < 16) { sG0[tid * 2] = R.pg; sG0[tid * 2 + 1] = R.pb; }
#pragma unroll
    for (int tau = 0; tau < 2; ++tau)
#pragma unroll
      for (int nt = 0; nt < 2; ++nt) {
        u32x2 w; w.x = pack2(St[tau][nt][0], St[tau][nt][1]); w.y = pack2(St[tau][nt][2], St[tau][nt][3]);
        *(u32x2*)(sSb + (nt * 16 + ln) * 136 + wave * 32 + tau * 16 + lg * 4) = w;
      }
    __syncthreads();
    if (t0 > 0) {
      bf16_t* ro = rawo + (size_t)(row0 + t0 - 16 + (tid >> 4)) * 1024 + ocol + (tid & 15);
      ro[0] = f2bf(o_prev0); ro[16] = f2bf(o_prev1);
    }
    if (t0 + 32 < 2048) prefetch(R, t0 + 32);
    if (tid < 16) {
      const float gc = sG0[tid * 2], gl = sG0[15 * 2];
      sG[tid * 4] = gc; sG[tid * 4 + 1] = __expf(gc); sG[tid * 4 + 2] = sG0[tid * 2 + 1]; sG[tid * 4 + 3] = __expf(gl - gc);
    }
    {
      const bf16_t* Ab = (wave & 1) ? sQb : sKb;
      const bf16_t* Bb = (wave < 2) ? sKb : sSb;
      f32x4v acc0, acc1;
#pragma unroll
      for (int e = 0; e < 4; ++e) { acc0[e] = 0.f; acc1[e] = 0.f; }
#pragma unroll
      for (int st = 0; st < 4; ++st) {
        bf16x8_t af = *(const bf16x8_t*)(Ab + ln * 136 + st * 32 + lg * 8);
        bf16x8_t bf = *(const bf16x8_t*)(Bb + ln * 136 + st * 32 + lg * 8);
        acc0 = __builtin_amdgcn_mfma_f32_16x16x32_bf16(af, bf, acc0, 0, 0, 0);
        if (wave >= 2) {
          bf16x8_t bf1 = *(const bf16x8_t*)(sSb + (16 + ln) * 136 + st * 32 + lg * 8);
          acc1 = __builtin_amdgcn_mfma_f32_16x16x32_bf16(af, bf1, acc1, 0, 0, 0);
        }
      }
      if (wave < 2) {
        float* dst = (wave == 0) ? sKK : sQK;
#pragma unroll
        for (int r = 0; r < 4; ++r) dst[(lg * 4 + r) * 17 + ln] = acc0[r];
      } else {
        float* dst = (wave == 2) ? sKS : sQS;
#pragma unroll
        for (int r = 0; r < 4; ++r) { dst[(lg * 4 + r) * 33 + ln] = acc0[r]; dst[(lg * 4 + r) * 33 + 16 + ln] = acc1[r]; }
      }
    }
    __syncthreads();
    {
      const int i = tid >> 4, j = tid & 15;
      const float gci = sG[i * 4], gcj = sG[j * 4], bi = sG[i * 4 + 2], egi = sG[i * 4 + 1];
      const float dec = __expf(fminf(gci - gcj, 0.f));
      sL[j * 20 + i] = (i > j) ? bi * sKK[i * 17 + j] * dec : 0.f;
      sA[i * 17 + j] = (i >= j) ? sQK[i * 17 + j] * dec : 0.f;
      sVnF[i * 33 + j] = bi * (sVf[i * 32 + j] - egi * sKS[i * 33 + j]);
      sVnF[i * 33 + 16 + j] = bi * (sVf[i * 32 + 16 + j] - egi * sKS[i * 33 + 16 + j]);
    }
    __syncthreads();
    if (tid >= 64) {
      for (int pr = tid - 64; pr < 256; pr += 192) {
        const int k = pr >> 1, hb = (pr & 1) * 8;
        unsigned w[4];
#pragma unroll
        for (int e = 0; e < 4; ++e) {
          float a0 = bf2f(sKb[(hb + 2 * e) * 136 + k]) * sG[(hb + 2 * e) * 4 + 3];
          float a1 = bf2f(sKb[(hb + 2 * e + 1) * 136 + k]) * sG[(hb + 2 * e + 1) * 4 + 3];
          w[e] = pack2(a0, a1);
        }
        *(u32x4*)(sKT + k * 40 + hb) = mk_u4(w[0], w[1], w[2], w[3]);
      }
    }
    if (tid < 32) {
      f32x2 vn2[8];
#pragma unroll
      for (int q = 0; q < 8; ++q) { vn2[q].x = sVnF[(2 * q) * 33 + tid]; vn2[q].y = sVnF[(2 * q + 1) * 33 + tid]; }
#pragma unroll
      for (int j = 0; j < 15; ++j) {
        const float vj = (j & 1) ? vn2[j >> 1].y : vn2[j >> 1].x;
        f32x2 vj2; vj2.x = vj; vj2.y = vj;
        f32x2 lt2[8];
#pragma unroll
        for (int q4 = (j + 1) >> 2; q4 < 4; ++q4) {
          const f32x4 v4 = *(const f32x4*)(sL + j * 20 + q4 * 4);
          lt2[q4 * 2] = v4.xy; lt2[q4 * 2 + 1] = v4.zw;
        }
#pragma unroll
        for (int q = (j + 1) >> 1; q < 8; ++q) vn2[q] -= lt2[q] * vj2;
      }
#pragma unroll
      for (int q = 0; q < 8; ++q) {
        sVnF[(2 * q) * 33 + tid] = vn2[q].x; sVnF[(2 * q + 1) * 33 + tid] = vn2[q].y;
        *(unsigned*)(sVn + tid * 40 + 2 * q) = pack2(vn2[q].x, vn2[q].y);
      }
    }
    __syncthreads();
    {
      const int i = tid >> 4, n = tid & 15;
      const float eg = sG[i * 4 + 1];
      float o0 = eg * sQS[i * 33 + n], o1 = eg * sQS[i * 33 + 16 + n];
#pragma unroll
      for (int j = 0; j < 16; ++j) { const float a = sA[i * 17 + j]; o0 += a * sVnF[j * 33 + n]; o1 += a * sVnF[j * 33 + 16 + n]; }
      o_prev0 = o0; o_prev1 = o1;
    }
    {
      const float egl = __expf(sG[15 * 4]);
      const bf16x8_t bf0 = *(const bf16x8_t*)(sVn + ln * 40 + lg * 8);
      const bf16x8_t bf1 = *(const bf16x8_t*)(sVn + (16 + ln) * 40 + lg * 8);
#pragma unroll
      for (int tau = 0; tau < 2; ++tau) {
        const bf16x8_t af = *(const bf16x8_t*)(sKT + (wave * 32 + tau * 16 + ln) * 40 + lg * 8);
        f32x4v a0 = St[tau][0] * egl, a1 = St[tau][1] * egl;
        St[tau][0] = __builtin_amdgcn_mfma_f32_16x16x32_bf16(af, bf0, a0, 0, 0, 0);
        St[tau][1] = __builtin_amdgcn_mfma_f32_16x16x32_bf16(af, bf1, a1, 0, 0, 0);
      }
    }
  };
#pragma unroll 1
  for (int t0 = 0; t0 < 2048; t0 += 32) { chunk_body(R0, t0); chunk_body(R1, t0 + 16); }
  {
    bf16_t* ro = rawo + (size_t)(row0 + 2048 - 16 + (tid >> 4)) * 1024 + ocol + (tid & 15);
    ro[0] = f2bf(o_prev0); ro[16] = f2bf(o_prev1);
  }
#pragma unroll
  for (int tau = 0; tau < 2; ++tau)
#pragma unroll
    for (int nt = 0; nt < 2; ++nt)
#pragma unroll
      for (int r = 0; r < 4; ++r)
        (p.out + oz)[O_GSP + (((size_t)b * 8 + hv) * 128 + wave * 32 + tau * 16 + lg * 4 + r) * 128 + sl4 * 32 + nt * 16 + ln] = St[tau][nt][r];
  __syncthreads();
}

__device__ __forceinline__ void phase_gdn_scan(const Params& p, char* smem) {
  const int oz = opaque_zero();
  const int bid = ((int)blockIdx.x + oz), G = gridDim.x;
  if (G == 512) {
    if (bid < 256) {
      gdn_chunk_item(p, bid >> 5, (bid >> 2) & 7, bid & 3, smem);
    } else {
      for (int j = bid - 256; j < 1024; j += 256) gdn_item(p, MP + (j >> 3) * 4, 4, false, j >> 3, j & 7, 0, 8, smem);
    }
  } else {
    for (int it = bid; it < 256 + 1024; it += G) {
      if (it < 256) gdn_chunk_item(p, it >> 5, (it >> 2) & 7, it & 3, smem);
      else { const int j = it - 256; gdn_item(p, MP + (j >> 3) * 4, 4, false, j >> 3, j & 7, 0, 8, smem); }
    }
  }
}

__device__ __forceinline__ void phase_gdn_post(const Params& p) {
  const int oz = opaque_zero();
  const int lane = ((int)threadIdx.x + oz) & 63;
  const int gw = ((int)blockIdx.x + oz) * 4 + (((int)threadIdx.x + oz) >> 6), nw = gridDim.x * 4;
  bf16_t* U = (bf16_t*)((p.ws + oz) + U_OFF);
  const bf16_t* rawo = (const bf16_t*)((p.ws + oz) + R_OFF);
  const int ch = lane * 16;
  float ng[16];
#pragma unroll
  for (int e = 0; e < 16; ++e) ng[e] = (p.in[37] + oz)[(ch + e) & 127];
  for (int row = gw; row < MT; row += nw) {
    float y[16];
    unpack8(*(const u32x4*)(rawo + (size_t)row * 1024 + ch), y);
    unpack8(*(const u32x4*)(rawo + (size_t)row * 1024 + ch + 8), y + 8);
    float q2 = 0.f;
#pragma unroll
    for (int e = 0; e < 16; ++e) q2 += y[e] * y[e];
    q2 = sum8(q2);
    float rs = rsqrtf(q2 * (1.f / 128.f) + 1e-6f);
    bf16_t* u = U + (size_t)row * GD_LDU;
    float zf[16];
    unpack8(*(const u32x4*)(u + 2048 + ch), zf); unpack8(*(const u32x4*)(u + 2048 + ch + 8), zf + 8);
    unsigned w[8];
#pragma unroll
    for (int e = 0; e < 8; ++e) {
      float o0 = y[2 * e] * rs * ng[2 * e] * siluf(zf[2 * e]);
      float o1 = y[2 * e + 1] * rs * ng[2 * e + 1] * siluf(zf[2 * e + 1]);
      w[e] = pack2(o0, o1);
    }
    *(u32x4*)(u + ch) = mk_u4(w[0], w[1], w[2], w[3]);
    *(u32x4*)(u + ch + 8) = mk_u4(w[4], w[5], w[6], w[7]);
  }
}

__device__ __forceinline__ void phase_final_ln(const Params& p, const float* stats, const float* g, const float* bta) {
  const int oz = opaque_zero();
  const int lane = ((int)threadIdx.x + oz) & 63;
  const int gw = ((int)blockIdx.x + oz) * 4 + (((int)threadIdx.x + oz) >> 6), nw = gridDim.x * 4;
  for (int r4 = gw * 4; r4 < MT; r4 += nw * 4) {
    float4 a[4][4];
    float mu[4], rs[4];
#pragma unroll
    for (int r = 0; r < 4; ++r) {
      const float4* z = (const float4*)((p.out + oz) + (size_t)(r4 + r) * 1024);
#pragma unroll
      for (int q = 0; q < 4; ++q) a[r][q] = z[q * 64 + lane];
      row_stats(stats, r4 + r, mu[r], rs[r]);
    }
#pragma unroll
    for (int q = 0; q < 4; ++q) {
      const float4 gg = *(const float4*)(g + (q * 64 + lane) * 4), bb = *(const float4*)(bta + (q * 64 + lane) * 4);
#pragma unroll
      for (int r = 0; r < 4; ++r) {
        float4 v = a[r][q];
        v.x = (v.x - mu[r]) * rs[r] * gg.x + bb.x; v.y = (v.y - mu[r]) * rs[r] * gg.y + bb.y;
        v.z = (v.z - mu[r]) * rs[r] * gg.z + bb.z; v.w = (v.w - mu[r]) * rs[r] * gg.w + bb.w;
        ((float4*)((p.out + oz) + (size_t)(r4 + r) * 1024))[q * 64 + lane] = v;
      }
    }
  }
}

#define BAR_OFF ((size_t)255426560)
#define XB_TMO      128
#define XB_XCNT(j)  (256  + 64 * (j))
#define XB_XSUB(j)  (1280 + 64 * (j))
#define XB_XGEN(j)  (2304 + 64 * (j))
#define XB_TOP      3328
#define XB_TOPGEN   3392
#define XCD_BAR_WORDS 3456
#define XB_SPIN_CAP (1u << 20)
#define LAS __attribute__((address_space(3)))
__device__ __forceinline__ unsigned xb_ld(unsigned* p)              { return __hip_atomic_load(p, __ATOMIC_RELAXED, __HIP_MEMORY_SCOPE_AGENT); }
__device__ __forceinline__ unsigned xb_add(unsigned* p, unsigned v) { return __hip_atomic_fetch_add(p, v, __ATOMIC_RELAXED, __HIP_MEMORY_SCOPE_AGENT); }
__device__ __forceinline__ unsigned xb_xcc_id() { return (unsigned)__builtin_amdgcn_s_getreg((3 << 11) | 20) & 0xFu; }
#define XB_SPIN(cond, bar) do { unsigned _sp = 0; while (cond) { __builtin_amdgcn_s_sleep(1); \
    if ((++_sp & 255u) == 0u) { if (xb_ld(&(bar)[XB_TMO])) break; if (_sp > XB_SPIN_CAP) { atomicAdd(&(bar)[XB_TMO], 1u); break; } } } } while (0)
struct XcdBarrier { unsigned* bar; unsigned x; volatile LAS unsigned* st; };
__device__ __forceinline__ XcdBarrier xcd_barrier_post(unsigned* bar, volatile LAS unsigned* st) {
  XcdBarrier b; b.bar = bar; b.x = xb_xcc_id(); b.st = st;
  if (threadIdx.x == 0) (void)xb_add(&bar[XB_XCNT(b.x)], 1u);
  return b;
}
__device__ __forceinline__ void xcd_barrier_complete(unsigned* bar, unsigned x, unsigned& nloc, unsigned& nx) {
  const unsigned G = gridDim.x * gridDim.y * gridDim.z;
  unsigned sum, cnt, mine, sp = 0u;
  for (;;) {
    sum = 0u; cnt = 0u; mine = 0u;
#pragma unroll
    for (unsigned j = 0; j < 16; ++j) { const unsigned c = xb_ld(&bar[XB_XCNT(j)]); sum += c; cnt += (c > 0u) ? 1u : 0u; mine = (j == x) ? c : mine; }
    if (sum == G) break;
    __builtin_amdgcn_s_sleep(1);
    if ((++sp & 255u) == 0u) { if (xb_ld(&bar[XB_TMO])) break; if (sp > XB_SPIN_CAP) { atomicAdd(&bar[XB_TMO], 1u); break; } }
  }
  nloc = mine > 0u ? mine : 1u; nx = cnt > 0u ? cnt : 1u;
}
__device__ __forceinline__ void xcd_barrier(const XcdBarrier& b) {
  asm volatile("s_waitcnt vmcnt(0)" ::: "memory");
  __syncthreads();
  if (threadIdx.x == 0) {
    unsigned* bar = b.bar;
    __builtin_amdgcn_s_waitcnt(0);
    unsigned nloc = b.st[0], nx = b.st[1];
    if (nloc == 0u) { xcd_barrier_complete(bar, b.x, nloc, nx); b.st[0] = nloc; b.st[1] = nx; }
    const unsigned old = xb_add(&bar[XB_XSUB(b.x)], 1u);
    const unsigned gen = old / nloc;
    if (old + 1u == (gen + 1u) * nloc) {
      __builtin_amdgcn_fence(__ATOMIC_RELEASE, "agent");
      asm volatile("s_waitcnt vmcnt(0)" ::: "memory");
      const unsigned og = xb_add(&bar[XB_TOP], 1u);
      const unsigned tg = og / nx;
      if (og + 1u == (tg + 1u) * nx) xb_add(&bar[XB_TOPGEN], 1u);
      else XB_SPIN(xb_ld(&bar[XB_TOPGEN]) == tg, bar);
      __builtin_amdgcn_fence(__ATOMIC_ACQUIRE, "agent");
      xb_add(&bar[XB_XGEN(b.x)], 1u);
      asm volatile("s_waitcnt vmcnt(0)" ::: "memory");
    } else {
      XB_SPIN(xb_ld(&bar[XB_XGEN(b.x)]) == gen, bar);
      __builtin_amdgcn_fence(__ATOMIC_ACQUIRE, "agent");
      asm volatile("s_waitcnt vmcnt(0)" ::: "memory");
    }
  }
  __syncthreads();
}

#ifndef REP_SYNC
#define REP_SYNC 0
#endif
#ifndef REP_RWS
#define REP_RWS 1
#endif
#ifndef REP_GDS
#define REP_GDS 1
#endif
#ifndef REP_LRU
#define REP_LRU 1
#endif
#ifndef REP_G1
#define REP_G1 1
#endif
#ifndef NLAYERS
#define NLAYERS 4
#endif
#define GSYNC() xcd_barrier(xb)
__global__ void __launch_bounds__(NTHREADS, 2) fwd_megakernel(Params p) {
  cg::grid_group grid = cg::this_grid();
  int oz = opaque_zero();
  __shared__ u32x4 xb_words;
  if (threadIdx.x == 0) xb_words = mk_u4(0u, 0u, 0u, 0u);
  __syncthreads();
  XcdBarrier xb = xcd_barrier_post((unsigned*)(p.ws + BAR_OFF), (volatile LAS unsigned*)&xb_words);
  if (oz != 0) grid.sync();
  __shared__ __attribute__((aligned(16))) char smem[63488];
  const bf16_t* WT = (const bf16_t*)(p.ws + oz);
  bf16_t* U = (bf16_t*)((p.ws + oz) + U_OFF);
  bf16_t* A2r = (bf16_t*)((p.ws + oz) + R_OFF);
  float* stats0 = (float*)((p.ws + oz) + STATS_OFF);
  float* stats1 = (float*)((p.ws + oz) + STATS_OFF + STATS_SZ);
  const float* lng = (p.in[8] + oz); const float* lnb = (p.in[9] + oz);
  XSrc xnone{nullptr, nullptr, nullptr, nullptr, nullptr};

  phase_convert(p, smem);
  {
    XSrc x0s{p.in[0] + oz, p.in[1] + oz, nullptr, nullptr, nullptr};
    phase_prepass(p, x0s, false);
  }
  for (int rep = 0; rep < REP_SYNC; ++rep) GSYNC();
  GSYNC();

#pragma unroll 1
  for (int layer = 0; layer < NLAYERS; ++layer) {
    oz = opaque_zero();
    const int kind = layer == 3 ? 0 : layer;
    const int la = layer == 3 ? 1 : 0;
    XSrc xin;
    xin.p0 = layer == 0 ? (p.in[0] + oz) : (p.out + oz);
    xin.p1 = layer == 0 ? (p.in[1] + oz) : (p.out + oz) + (size_t)MP * DM;
    xin.stats = layer == 0 ? nullptr : ((layer & 1) ? stats0 : stats1);
    xin.g = lng + (layer == 0 ? 0 : (layer - 1) * 1024);
    xin.b = lnb + (layer == 0 ? 0 : (layer - 1) * 1024);
    float* stout = (layer & 1) ? stats1 : stats0;
    const bf16_t* Win = kind == 0 ? WT + W_LRUWIN(la) : (kind == 1 ? WT + W_RWWIN : WT + W_GDNWIN);
    const int NT1 = kind == 0 ? 16 : (kind == 1 ? 34 : 25);
    const int ldu = kind == 0 ? 2048 : (kind == 1 ? RW_LDU : GD_LDU);
    if (layer > 0) {
      phase_prepass(p, xin, kind == 1);
      GSYNC();
    }
    {
      const bf16_t* XA = (const bf16_t*)((p.ws + oz) + R_OFF);
      const bf16_t* XS = (const bf16_t*)((p.ws + oz) + XS_OFF);
      for (int rep = 0; rep < REP_G1; ++rep)
      if (kind == 1) gemm_phase<0, true>(XA, 1024, (p.in[19] + oz), XS, Win, 1024, NT1, U, ldu, xnone, nullptr, nullptr, smem);
      else gemm_phase<0, false>(XA, 1024, nullptr, nullptr, Win, 1024, NT1, U, ldu, xnone, nullptr, nullptr, smem);
    }
    GSYNC();
    if (kind == 0) {
      phase_lru_heavy(p, la, smem);
      GSYNC();
      phase_lru_carry(p, la);
      GSYNC();
      phase_lru_light(p);
      GSYNC();
    } else if (kind == 1) {
      phase_rwkv_pre(p, smem);
      GSYNC();
      phase_rwkv_scan(p, smem);
      GSYNC();
      phase_rwkv_post(p, xin);
      GSYNC();
    } else {
      phase_gdn_pre(p);
      GSYNC();
      phase_gdn_scan(p, smem);
      GSYNC();
      phase_gdn_post(p);
      GSYNC();
    }
    const bf16_t* A2 = kind == 0 ? A2r : U;
    const int lda2 = kind == 0 ? 1024 : ldu;
    const bf16_t* Wout = kind == 0 ? WT + W_LRUWOUT(la) : (kind == 1 ? WT + W_RWWOUT : WT + W_GDNWOUT);
    gemm_phase<1, false>(A2, lda2, nullptr, nullptr, Wout, 1024, 8, nullptr, 0, xin, (p.out + oz), stout, smem);
    GSYNC();
  }

  phase_final_ln(p, ((NLAYERS - 1) & 1) ? stats1 : stats0, lng + (NLAYERS - 1) * 1024, lnb + (NLAYERS - 1) * 1024);
}

extern "C" void kernel_launch(void* const* d_in, const int* in_sizes, int n_in, void* d_out, int out_size,
                              void* d_ws, size_t ws_size, hipStream_t stream) {
  static int grid_blocks = 0;
  if (!grid_blocks) {
    int dev = 0, cus = 0, per_cu = 0;
    hipGetDevice(&dev);
    hipDeviceGetAttribute(&cus, hipDeviceAttributeMultiprocessorCount, dev);
    hipOccupancyMaxActiveBlocksPerMultiprocessor(&per_cu, fwd_megakernel, NTHREADS, 0);
    if (per_cu < 1) per_cu = 1;
    if (per_cu > 2) per_cu = 2;
    grid_blocks = cus * per_cu;
  }
  Params p;
  memset(&p, 0, sizeof(p));
  for (int i = 0; i < 39; ++i) p.in[i] = (const float*)d_in[i];
  p.out = (float*)d_out;
  p.ws = (char*)d_ws;
  (void)hipMemsetAsync((char*)d_ws + BAR_OFF, 0, XCD_BAR_WORDS * sizeof(unsigned), stream);
  void* args[] = {&p};
  hipError_t e = hipLaunchCooperativeKernel((void*)fwd_megakernel, dim3(grid_blocks), dim3(NTHREADS), args, 0, stream);
  if (e != hipSuccess) fprintf(stderr, "cooperative launch failed: %s (grid %d)\n", hipGetErrorString(e), grid_blocks);
}
```

```cpp
#include <hip/hip_runtime.h>
#include <hip/hip_cooperative_groups.h>
#include <cstdio>
#include <cstring>
namespace cg = cooperative_groups;

typedef unsigned short bf16_t;
typedef __attribute__((ext_vector_type(8))) short bf16x8_t;
typedef __attribute__((ext_vector_type(16))) float f32x16;
typedef __attribute__((ext_vector_type(4))) unsigned u32x4;
typedef __attribute__((ext_vector_type(2))) unsigned u32x2;
typedef __attribute__((ext_vector_type(2))) float f32x2;
typedef __attribute__((ext_vector_type(4))) float f32x4v;
typedef __attribute__((ext_vector_type(4))) float f32x4;
__device__ __forceinline__ u32x4 mk_u4(unsigned a, unsigned b, unsigned c, unsigned d) { u32x4 r; r.x = a; r.y = b; r.z = c; r.w = d; return r; }

#define DM 1024
#define MP 16384
#define MS 512
#define MT 16896
#define NTHREADS 256

#define O_Y        0L
#define O_LRUCONVP 17301504L
#define O_LRUCONVS 17350656L
#define O_LRUHP    18137088L
#define O_LRUHS    18153472L
#define O_SHIFTP   18415616L
#define O_SHIFTS   18423808L
#define O_WKVP     18554880L
#define O_WKVS     19079168L
#define O_GCONVP   27467776L
#define O_GCONVS   27516928L
#define O_GSP      28303360L
#define O_GSS      29351936L

#define W_LRUWIN(l)  ((size_t)(l) * 2097152)
#define W_LRUWOUT(l) ((size_t)4194304 + (size_t)(l) * 1048576)
#define W_LRUWA(l)   ((size_t)6291456 + (size_t)(l) * 65536)
#define W_LRUWX(l)   ((size_t)6422528 + (size_t)(l) * 65536)
#define W_RWWIN      ((size_t)6553600)
#define W_RWW2T      ((size_t)11010048)
#define W_RWA2T      ((size_t)11075584)
#define W_RWWOUT     ((size_t)11141120)
#define W_GDNWIN     ((size_t)12189696)
#define W_GDNWOUT    ((size_t)15466496)
#define U_OFF     ((size_t)33554432)
#define R_OFF     ((size_t)180617216)
#define STATS_OFF ((size_t)249823232)
#define STATS_SZ  ((size_t)1081344)
#define SUMM_OFF  ((size_t)251985920)
#define BONUS_OFF ((size_t)254083072)

#define DN_ALPHA 1.681792830507429f

struct Params {
  const float* in[39];
  float* out;
  char* ws;
};

struct XSrc { const float* p0; const float* p1; const float* stats; const float* g; const float* b; };

__device__ __forceinline__ unsigned cvt_pk_bf16(float lo, float hi) {
  unsigned r;
  asm("v_cvt_pk_bf16_f32 %0, %1, %2" : "=v"(r) : "v"(lo), "v"(hi));
  return r;
}
__device__ __forceinline__ bf16_t f2bf(float f) { return (bf16_t)(cvt_pk_bf16(f, 0.f) & 0xffffu); }
__device__ __forceinline__ float bf2f(bf16_t h) { return __uint_as_float(((unsigned)h) << 16); }
__device__ __forceinline__ unsigned pack2(float lo, float hi) { return cvt_pk_bf16(lo, hi); }
__device__ __forceinline__ float bflo(unsigned w) { return __uint_as_float(w << 16); }
__device__ __forceinline__ float bfhi(unsigned w) { return __uint_as_float(w & 0xffff0000u); }
__device__ __forceinline__ float sigm(float x) { return __builtin_amdgcn_rcpf(1.f + __expf(-x)); }
__device__ __forceinline__ float ftanh(float x) { float e = __expf(2.f * x); return 1.f - 2.f * __builtin_amdgcn_rcpf(1.f + e); }
__device__ __forceinline__ float siluf(float x) { return x * sigm(x); }
__device__ __forceinline__ float softplusf(float x) { return fmaxf(x, 0.f) + log1pf(expf(-fabsf(x))); }

__device__ __forceinline__ int opaque_zero() { int z; asm volatile("s_mov_b32 %0, 0" : "=s"(z)); return z; }
template <int CTRL> __device__ __forceinline__ float dppf(float x) {
  return __builtin_bit_cast(float, __builtin_amdgcn_mov_dpp(__builtin_bit_cast(int, x), CTRL, 0xf, 0xf, true));
}
__device__ __forceinline__ float sum4(float x) { x += dppf<0xB1>(x); x += dppf<0x4E>(x); return x; }
__device__ __forceinline__ float sum8(float x) { x = sum4(x); x += dppf<0x141>(x); return x; }
__device__ __forceinline__ float sum16(float x) { x = sum8(x); x += dppf<0x140>(x); return x; }

__device__ __forceinline__ void unpack8(const u32x4 q, float* f) {
  f[0] = bflo(q.x); f[1] = bfhi(q.x); f[2] = bflo(q.y); f[3] = bfhi(q.y);
  f[4] = bflo(q.z); f[5] = bfhi(q.z); f[6] = bflo(q.w); f[7] = bfhi(q.w);
}

__device__ __forceinline__ void row_stats(const float* st, int row, float& mu, float& rstd) {
  const float4* p = (const float4*)(st + (size_t)row * 16);
  float4 a = p[0], b = p[1], c = p[2], d = p[3];
  float s = a.x + a.z + b.x + b.z + c.x + c.z + d.x + d.z;
  float q = a.y + a.w + b.y + b.w + c.y + c.w + d.y + d.w;
  mu = s * (1.f / 1024.f);
  float var = q * (1.f / 1024.f) - mu * mu;
  rstd = rsqrtf(fmaxf(var, 0.f) + 1e-5f);
}
__device__ __forceinline__ const float* xrow(const XSrc& xs, int row) {
  return row < MP ? xs.p0 + (size_t)row * DM : xs.p1 + (size_t)(row - MP) * DM;
}

__device__ __forceinline__ void convert_tile(const float* j_src, bf16_t* j_dst, int j_K, int j_Nsrc, int j_lds, int j_ldd,
                                             int j_sb, int j_db, int j_ntn, int lt, char* smem) {
  const int oz = opaque_zero();
  float* sT = (float*)smem;
  int nkt = j_K >> 6;
  int per_b = nkt * j_ntn;
  int bi = lt / per_b; int r = lt - bi * per_b;
  int kt = r / j_ntn; int nt = r - kt * j_ntn;
  const float* src = j_src + (size_t)bi * j_sb;
  bf16_t* dst = j_dst + (size_t)bi * j_db;
  int k0 = kt * 64, n0 = nt * 64;
  int tid = ((int)threadIdx.x + oz);
  int nn = tid & 63, kb = tid >> 6;
  int n = n0 + nn;
#pragma unroll
  for (int i = 0; i < 16; ++i) {
    int kk = kb + 4 * i;
    float v = (n < j_Nsrc) ? src[(size_t)(k0 + kk) * j_lds + n] : 0.f;
    sT[kk * 65 + nn] = v;
  }
  __syncthreads();
  int nr = tid >> 2, kq = (tid & 3) * 16;
  unsigned w[8];
#pragma unroll
  for (int e = 0; e < 8; ++e) w[e] = pack2(sT[(kq + 2 * e) * 65 + nr], sT[(kq + 2 * e + 1) * 65 + nr]);
  u32x4* d = (u32x4*)(dst + (size_t)(n0 + nr) * j_ldd + k0 + kq);
  d[0] = mk_u4(w[0], w[1], w[2], w[3]);
  d[1] = mk_u4(w[4], w[5], w[6], w[7]);
  __syncthreads();
}

#define NCONV_TILES 4032
__device__ __forceinline__ void phase_convert(const Params& p, char* smem) {
  const int oz = opaque_zero();
  bf16_t* WT = (bf16_t*)(p.ws + oz);
  for (int t = ((int)blockIdx.x + oz); t < NCONV_TILES; t += gridDim.x) {
    const float* j_src; bf16_t* j_dst; int j_K, j_Nsrc, j_lds, j_ldd, j_sb, j_db, j_ntn, j_t0;
#define JOBSET(SRC, DST, K_, NSRC, NDST, LDS_, LDD_, SB_, DB_, T0) { j_src = SRC; j_dst = DST; j_K = K_; j_Nsrc = NSRC; j_ntn = (NDST) / 64; j_lds = LDS_; j_ldd = LDD_; j_sb = SB_; j_db = DB_; j_t0 = T0; }
    if (t < 512)       JOBSET((p.in[10] + oz), WT + W_LRUWIN(0), 1024, 2048, 2048, 2048, 1024, 0, 0, 0)
    else if (t < 1024) JOBSET((p.in[10] + oz) + (size_t)1024 * 2048, WT + W_LRUWIN(1), 1024, 2048, 2048, 2048, 1024, 0, 0, 512)
    else if (t < 1280) JOBSET((p.in[18] + oz), WT + W_LRUWOUT(0), 1024, 1024, 1024, 1024, 1024, 0, 0, 1024)
    else if (t < 1536) JOBSET((p.in[18] + oz) + (size_t)1048576, WT + W_LRUWOUT(1), 1024, 1024, 1024, 1024, 1024, 0, 0, 1280)
    else if (t < 1552) JOBSET((p.in[13] + oz), WT + W_LRUWA(0), 64, 64, 64, 64, 64, 4096, 4096, 1536)
    else if (t < 1568) JOBSET((p.in[13] + oz) + 65536, WT + W_LRUWA(1), 64, 64, 64, 64, 64, 4096, 4096, 1552)
    else if (t < 1584) JOBSET((p.in[15] + oz), WT + W_LRUWX(0), 64, 64, 64, 64, 64, 4096, 4096, 1568)
    else if (t < 1600) JOBSET((p.in[15] + oz) + 65536, WT + W_LRUWX(1), 64, 64, 64, 64, 64, 4096, 4096, 1584)
    else if (t < 2624) JOBSET((p.in[20] + oz), WT + W_RWWIN, 1024, 1024, 1024, 1024, 1024, 1048576, 1048576, 1600)
    else if (t < 2656) JOBSET((p.in[22] + oz), WT + W_RWWIN + (size_t)4096 * 1024, 1024, 64, 128, 64, 1024, 0, 0, 2624)
    else if (t < 2688) JOBSET((p.in[25] + oz), WT + W_RWWIN + (size_t)4224 * 1024, 1024, 64, 128, 64, 1024, 0, 0, 2656)
    else if (t < 2704) JOBSET((p.in[23] + oz), WT + W_RWW2T, 64, 1024, 1024, 1024, 64, 0, 0, 2688)
    else if (t < 2720) JOBSET((p.in[26] + oz), WT + W_RWA2T, 64, 1024, 1024, 1024, 64, 0, 0, 2704)
    else if (t < 2976) JOBSET((p.in[32] + oz), WT + W_RWWOUT, 1024, 1024, 1024, 1024, 1024, 0, 0, 2720)
    else if (t < 3776) JOBSET((p.in[33] + oz), WT + W_GDNWIN, 1024, 3088, 3200, 3088, 1024, 0, 0, 2976)
    else               JOBSET((p.in[38] + oz), WT + W_GDNWOUT, 1024, 1024, 1024, 1024, 1024, 0, 0, 3776)
    convert_tile(j_src, j_dst, j_K, j_Nsrc, j_lds, j_ldd, j_sb, j_db, j_ntn, t - j_t0, smem);
  }
}

#define XS_OFF ((size_t)255164416)
__device__ __forceinline__ void phase_prepass(const Params& p, const XSrc xin, bool want_shift) {
  const int oz = opaque_zero();
  const int lane = ((int)threadIdx.x + oz) & 63;
  const int gw = ((int)blockIdx.x + oz) * 4 + (((int)threadIdx.x + oz) >> 6), nw = gridDim.x * 4;
  bf16_t* XA = (bf16_t*)((p.ws + oz) + R_OFF);
  const bool ln = xin.stats != nullptr;
  const int ch = lane * 16;
  float4 ggq[4], bbq[4];
#pragma unroll
  for (int q = 0; q < 4; ++q) {
    ggq[q] = make_float4(1.f, 1.f, 1.f, 1.f); bbq[q] = make_float4(0.f, 0.f, 0.f, 0.f);
    if (ln) { ggq[q] = *(const float4*)(xin.g + (q * 64 + lane) * 4); bbq[q] = *(const float4*)(xin.b + (q * 64 + lane) * 4); }
  }
  for (int r4 = gw * 4; r4 < MT; r4 += nw * 4) {
    float4 a[4][4];
    float mu[4], rs[4];
#pragma unroll
    for (int r = 0; r < 4; ++r) {
      const float* z = xrow(xin, r4 + r);
#pragma unroll
      for (int q = 0; q < 4; ++q) a[r][q] = *(const float4*)(z + (q * 64 + lane) * 4);
      mu[r] = 0.f; rs[r] = 1.f;
      if (ln) row_stats(xin.stats, r4 + r, mu[r], rs[r]);
    }
#pragma unroll
    for (int q = 0; q < 4; ++q) {
      const float4 gg = ggq[q], bb = bbq[q];
#pragma unroll
      for (int r = 0; r < 4; ++r) {
        float4 v = a[r][q];
        if (ln) {
          v.x = (v.x - mu[r]) * rs[r] * gg.x + bb.x; v.y = (v.y - mu[r]) * rs[r] * gg.y + bb.y;
          v.z = (v.z - mu[r]) * rs[r] * gg.z + bb.z; v.w = (v.w - mu[r]) * rs[r] * gg.w + bb.w;
        }
        u32x2 w; w.x = pack2(v.x, v.y); w.y = pack2(v.z, v.w);
        *(u32x2*)(XA + (size_t)(r4 + r) * DM + (q * 64 + lane) * 4) = w;
      }
    }
  }
  if (want_shift) {
    bf16_t* XS = (bf16_t*)((p.ws + oz) + XS_OFF);
    const float* st = (p.in[4] + oz);
    for (int b = gw; b < 128; b += nw) {
      float v[16];
#pragma unroll
      for (int q = 0; q < 4; ++q) {
        float4 a = *(const float4*)(st + (size_t)b * DM + ch + q * 4);
        v[q * 4] = a.x; v[q * 4 + 1] = a.y; v[q * 4 + 2] = a.z; v[q * 4 + 3] = a.w;
      }
      *(u32x4*)(XS + (size_t)b * DM + ch) = mk_u4(pack2(v[0], v[1]), pack2(v[2], v[3]), pack2(v[4], v[5]), pack2(v[6], v[7]));
      *(u32x4*)(XS + (size_t)b * DM + ch + 8) = mk_u4(pack2(v[8], v[9]), pack2(v[10], v[11]), pack2(v[12], v[13]), pack2(v[14], v[15]));
    }
  }
}

#define GEMM_SWZ 1
#define GEMM_LDS_STAT 36864
template <int EPI, bool MIX>
__device__ __forceinline__ void gemm_phase(const bf16_t* Abf, int lda, const float* mixmu, const bf16_t* XS,
                           const bf16_t* Bt, int K, int NT,
                           bf16_t* C, int ldc,
                           const XSrc res, float* zout, float* statsOut,
                           char* smem) {
  const int oz = opaque_zero();
  bf16_t* As = (bf16_t*)smem;
  bf16_t* Bs = As + 128 * 72;
  float* sRS = (float*)(smem + GEMM_LDS_STAT);
  float* sMu = (float*)(smem + GEMM_LDS_STAT + 1024);
  const int tid = ((int)threadIdx.x + oz), lane = tid & 63, wave = tid >> 6;
  const int wm = wave >> 1, wn = wave & 1;
  const int lr = lane & 31, lh = lane >> 5;
  const int tiles = 132 * NT;
  const int tpx = (tiles + 7) >> 3;
  const int nk = K >> 6;
  int cur_mix = -1;

  for (int t = ((int)blockIdx.x + oz); t < 8 * tpx; t += gridDim.x) {
#if GEMM_SWZ
    int lt = (t & 7) * tpx + (t >> 3);
#else
    int lt = t;
#endif
    if (lt >= tiles) continue;
    int mt, nt;
    {
      const int pn = lt / (8 * NT), r = lt - pn * 8 * NT;
      const int hM = min(8, 132 - pn * 8);
      const int nsn = (NT + 7) >> 3;
      const int sn = min(r / (hM * 8), nsn - 1);
      const int r2 = r - sn * hM * 8;
      const int w = min(8, NT - sn * 8);
      const int mi = r2 / w;
      mt = pn * 8 + mi; nt = sn * 8 + (r2 - mi * w);
    }
    const int m0 = mt * 128, n0 = nt * 128;
    const bool isP = m0 < MP;

    if (EPI == 1) {
      if (tid < 128) {
        float mu = 0.f, rs = 1.f;
        if (res.stats != nullptr) row_stats(res.stats, m0 + tid, mu, rs);
        sRS[tid * 2] = mu; sRS[tid * 2 + 1] = rs;
      }
    }
    if (MIX) {
      const int mixn_ = nt < 32 ? (nt >> 3) : (nt == 32 ? 4 : 5);
      if (mixn_ != cur_mix) { *(float4*)(sMu + tid * 4) = *(const float4*)(mixmu + mixn_ * DM + tid * 4); cur_mix = mixn_; }
    }
    __syncthreads();

    f32x16 acc[2][2];
#pragma unroll
    for (int a = 0; a < 2; ++a)
#pragma unroll
      for (int b = 0; b < 2; ++b)
#pragma unroll
        for (int e = 0; e < 16; ++e) acc[a][b][e] = 0.f;

    struct Stage { u32x4 a[4]; u32x4 b[4]; u32x4 px; };
    Stage st0, st1;
    const int bc = tid & 7, brb = tid >> 3;
    int mixn = 0;
    if (MIX) mixn = nt < 32 ? (nt >> 3) : (nt == 32 ? 4 : 5);
    const bf16_t* aptr = Abf + (size_t)(m0 + brb * 4) * lda + bc * 8;
    const bf16_t* bptr = Bt + (size_t)(n0 + brb) * K + bc * 8;

    auto loadAB = [&](Stage& st, int kt) __attribute__((always_inline)) {
      const int k0 = kt * 64;
#pragma unroll
      for (int i = 0; i < 4; ++i) st.a[i] = *(const u32x4*)(aptr + (size_t)i * lda + k0);
#pragma unroll
      for (int i = 0; i < 4; ++i) st.b[i] = *(const u32x4*)(bptr + (size_t)(32 * i) * K + k0);
      if (MIX) {
        st.px = mk_u4(0, 0, 0, 0);
        const int row = m0 + brb * 4;
        if (isP) { if ((row & 2047) != 0) st.px = *(const u32x4*)(aptr - lda + k0); }
        else st.px = *(const u32x4*)(XS + (size_t)((row - MP) >> 2) * DM + k0 + bc * 8);
      }
    };
    auto storeAB = [&](Stage& st, int kt) __attribute__((always_inline)) {
      if (MIX) {
        float pv[8];
        unpack8(st.px, pv);
        const float4 mu0 = *(const float4*)(sMu + kt * 64 + bc * 8), mu1 = *(const float4*)(sMu + kt * 64 + bc * 8 + 4);
#pragma unroll
        for (int i = 0; i < 4; ++i) {
          float x[8];
          unpack8(st.a[i], x);
          u32x4 w;
          w.x = pack2(x[0] + (pv[0] - x[0]) * mu0.x, x[1] + (pv[1] - x[1]) * mu0.y);
          w.y = pack2(x[2] + (pv[2] - x[2]) * mu0.z, x[3] + (pv[3] - x[3]) * mu0.w);
          w.z = pack2(x[4] + (pv[4] - x[4]) * mu1.x, x[5] + (pv[5] - x[5]) * mu1.y);
          w.w = pack2(x[6] + (pv[6] - x[6]) * mu1.z, x[7] + (pv[7] - x[7]) * mu1.w);
          *(u32x4*)(As + (brb * 4 + i) * 72 + bc * 8) = w;
#pragma unroll
          for (int e = 0; e < 8; ++e) pv[e] = x[e];
        }
      } else {
#pragma unroll
        for (int i = 0; i < 4; ++i) *(u32x4*)(As + (brb * 4 + i) * 72 + bc * 8) = st.a[i];
      }
#pragma unroll
      for (int i = 0; i < 4; ++i) *(u32x4*)(Bs + (brb + 32 * i) * 72 + bc * 8) = st.b[i];
    };
    auto compute = [&]() __attribute__((always_inline)) {
      bf16x8_t af[4][2], bfr[4][2];
      const bf16_t* ap = As + (wm * 64 + lr) * 72 + lh * 8;
      const bf16_t* bp = Bs + (wn * 64 + lr) * 72 + lh * 8;
#define LDFRAG(ks) { af[ks][0] = *(const bf16x8_t*)(ap + ks * 16); af[ks][1] = *(const bf16x8_t*)(ap + 32 * 72 + ks * 16); \
                     bfr[ks][0] = *(const bf16x8_t*)(bp + ks * 16); bfr[ks][1] = *(const bf16x8_t*)(bp + 32 * 72 + ks * 16); }
#define MMA4(ks) { acc[0][0] = __builtin_amdgcn_mfma_f32_32x32x16_bf16(af[ks][0], bfr[ks][0], acc[0][0], 0, 0, 0); \
                   acc[0][1] = __builtin_amdgcn_mfma_f32_32x32x16_bf16(af[ks][0], bfr[ks][1], acc[0][1], 0, 0, 0); \
                   acc[1][0] = __builtin_amdgcn_mfma_f32_32x32x16_bf16(af[ks][1], bfr[ks][0], acc[1][0], 0, 0, 0); \
                   acc[1][1] = __builtin_amdgcn_mfma_f32_32x32x16_bf16(af[ks][1], bfr[ks][1], acc[1][1], 0, 0, 0); }
      LDFRAG(0) LDFRAG(1)
      __builtin_amdgcn_sched_barrier(0);
      MMA4(0)
      LDFRAG(2)
      __builtin_amdgcn_sched_barrier(0);
      MMA4(1)
      LDFRAG(3)
      __builtin_amdgcn_sched_barrier(0);
      MMA4(2)
      MMA4(3)
#undef LDFRAG
#undef MMA4
    };

    loadAB(st0, 0);
    loadAB(st1, 1);
#pragma unroll 1
    for (int kt = 0; kt < nk; kt += 2) {
      __syncthreads();
      storeAB(st0, kt);
      __syncthreads();
      if (kt + 2 < nk) loadAB(st0, kt + 2);
      compute();
      __syncthreads();
      storeAB(st1, kt + 1);
      __syncthreads();
      if (kt + 3 < nk) loadAB(st1, kt + 3);
      compute();
    }

    __syncthreads();
    if (EPI == 0) {
      bf16_t* sC = (bf16_t*)smem;
#pragma unroll
      for (int mi = 0; mi < 2; ++mi)
#pragma unroll
        for (int ni = 0; ni < 2; ++ni)
#pragma unroll
          for (int e = 0; e < 16; ++e) {
            int rl = wm * 64 + mi * 32 + (e & 3) + 8 * (e >> 2) + 4 * lh;
            int cl = wn * 64 + ni * 32 + lr;
            sC[rl * 136 + cl] = f2bf(acc[mi][ni][e]);
          }
      __syncthreads();
#pragma unroll
      for (int i = 0; i < 8; ++i) {
        int idx = tid + 256 * i;
        int rl = idx >> 4, ck = idx & 15;
        u32x4 v = *(const u32x4*)(sC + rl * 136 + ck * 8);
        *(u32x4*)(C + (size_t)(m0 + rl) * ldc + n0 + ck * 8) = v;
      }
      __syncthreads();
    } else {
      float* sC = (float*)smem;
      const bool ln = res.stats != nullptr;
      const float* rbase = isP ? res.p0 + (size_t)m0 * DM : res.p1 + (size_t)(m0 - MP) * DM;
      const int er = tid >> 2, ec = (tid & 3) * 32;
      float4 gq[8], bq[8];
#pragma unroll
      for (int q = 0; q < 8; ++q) {
        gq[q] = make_float4(1.f, 1.f, 1.f, 1.f); bq[q] = make_float4(0.f, 0.f, 0.f, 0.f);
        if (ln) { gq[q] = *(const float4*)(res.g + n0 + ec + q * 4); bq[q] = *(const float4*)(res.b + n0 + ec + q * 4); }
      }
#pragma unroll
      for (int mi = 0; mi < 2; ++mi) {
#pragma unroll
        for (int ni = 0; ni < 2; ++ni)
#pragma unroll
          for (int e = 0; e < 16; ++e) {
            int rl = wm * 32 + (e & 3) + 8 * (e >> 2) + 4 * lh;
            int cl = wn * 64 + ni * 32 + lr;
            sC[rl * 132 + cl] = acc[mi][ni][e];
          }
        __syncthreads();
        {
          const int rl = (er >> 5) * 64 + mi * 32 + (er & 31);
          float mu = 0.f, rs = 1.f;
          if (ln) { mu = sRS[rl * 2]; rs = sRS[rl * 2 + 1]; }
          float s_ = 0.f, q_ = 0.f;
          float4 xr[8];
#pragma unroll
          for (int q = 0; q < 8; ++q) xr[q] = *(const float4*)(rbase + (size_t)rl * DM + n0 + ec + q * 4);
#pragma unroll
          for (int q = 0; q < 8; ++q) {
            const int cl = ec + q * 4;
            float4 c4 = *(const float4*)(sC + er * 132 + cl);
            float4 x4 = xr[q];
            if (ln) {
              float4 gg = gq[q], bb = bq[q];
              x4.x = (x4.x - mu) * rs * gg.x + bb.x; x4.y = (x4.y - mu) * rs * gg.y + bb.y;
              x4.z = (x4.z - mu) * rs * gg.z + bb.z; x4.w = (x4.w - mu) * rs * gg.w + bb.w;
            }
            float4 z;
            z.x = DN_ALPHA * x4.x + c4.x; z.y = DN_ALPHA * x4.y + c4.y;
            z.z = DN_ALPHA * x4.z + c4.z; z.w = DN_ALPHA * x4.w + c4.w;
            *(float4*)(zout + (size_t)(m0 + rl) * DM + n0 + cl) = z;
            s_ += z.x + z.y + z.z + z.w;
            q_ += z.x * z.x + z.y * z.y + z.z * z.z + z.w * z.w;
          }
          s_ = sum4(s_); q_ = sum4(q_);
          if ((tid & 3) == 0) {
            statsOut[(size_t)(m0 + rl) * 16 + nt * 2] = s_;
            statsOut[(size_t)(m0 + rl) * 16 + nt * 2 + 1] = q_;
          }
        }
        __syncthreads();
      }
    }
  }
}

#define LA_OFF ((size_t)102760448)
#define LB_OFF ((size_t)137363456)
template <int MODE>
__device__ __forceinline__ void lru_tile(const Params& p, int la, int tt, int nb, char* smem) {
  const int oz = opaque_zero();
  float* sX = (float*)smem;
  float* sR = (float*)smem;
  float* sI = (float*)(smem + 17152);
  bf16_t* sA = (bf16_t*)(smem + 33536);
  bf16_t* sWa = (bf16_t*)(smem + 42752);
  bf16_t* sWx = (bf16_t*)(smem + 51968);
  float* sSeg = (float*)(smem + 61184);

  const int tid = ((int)threadIdx.x + oz), lane = tid & 63, wave = tid >> 6;
  const bf16_t* U = (const bf16_t*)((p.ws + oz) + U_OFF);
  const bf16_t* WT = (const bf16_t*)(p.ws + oz);
  const int r0 = tt * 64;
  const bool isP = r0 < MP;
  const int Tseq = isP ? 2048 : 4;
  const int ch0 = nb * 64;

  {
    int c8 = tid & 7;
#pragma unroll
    for (int i = 0; i < 3; ++i) {
      int mm = (tid >> 3) + 32 * i;
      if (mm < 67) {
        int row = r0 - 3 + mm;
        float f[8];
        if (row >= 0) {
          u32x4 q = *(const u32x4*)(U + (size_t)row * 2048 + ch0 + c8 * 8);
          unpack8(q, f);
        } else {
#pragma unroll
          for (int e = 0; e < 8; ++e) f[e] = 0.f;
        }
#pragma unroll
        for (int e = 0; e < 8; ++e) sX[mm * 64 + c8 * 8 + e] = f[e];
      }
    }
    const bf16_t* wa = WT + W_LRUWA(la) + (size_t)nb * 4096;
    const bf16_t* wx = WT + W_LRUWX(la) + (size_t)nb * 4096;
#pragma unroll
    for (int i = 0; i < 2; ++i) {
      int row = (tid >> 3) + 32 * i;
      *(u32x4*)(sWa + row * 72 + c8 * 8) = *(const u32x4*)(wa + row * 64 + c8 * 8);
      *(u32x4*)(sWx + row * 72 + c8 * 8) = *(const u32x4*)(wx + row * 64 + c8 * 8);
    }
  }
  __syncthreads();

  const int c = tid & 63, s = tid >> 6;
  const int gch = ch0 + c;
  float xc[16];
  {
    const float* cw = (p.in[11] + oz) + (size_t)la * 4096;
    float w0 = cw[gch], w1 = cw[1024 + gch], w2 = cw[2048 + gch], w3 = cw[3072 + gch];
    float cb = (p.in[12] + oz)[la * 1024 + gch];
    const float* cst = (p.in[2] + oz) + (size_t)la * 128 * 3 * 1024;
    float* oconv = (p.out + oz) + (isP ? O_LRUCONVP + (size_t)la * 8 * 3 * 1024 : O_LRUCONVS + (size_t)la * 128 * 3 * 1024);
#pragma unroll
    for (int i = 0; i < 16; ++i) {
      int m = s * 16 + i;
      int row = r0 + m;
      int t, b;
      if (isP) { t = row & 2047; b = row >> 11; } else { t = m & 3; b = (row - MP) >> 2; }
      float v0, v1, v2;
      float v3 = sX[(m + 3) * 64 + c];
      if (t >= 3) { v0 = sX[m * 64 + c]; v1 = sX[(m + 1) * 64 + c]; v2 = sX[(m + 2) * 64 + c]; }
      else {
        const float* bb = cst + (size_t)b * 3 * 1024 + gch;
        v0 = isP ? 0.f : bb[(size_t)t * 1024];
        v1 = (t + 1 >= 3) ? sX[(m + 1) * 64 + c] : (isP ? 0.f : bb[(size_t)(t + 1) * 1024]);
        v2 = (t + 2 >= 3) ? sX[(m + 2) * 64 + c] : (isP ? 0.f : bb[(size_t)(t + 2) * 1024]);
      }
      float v = cb + w0 * v0 + w1 * v1 + w2 * v2 + w3 * v3;
      xc[i] = v;
      sA[m * 72 + c] = f2bf(v);
      if (MODE == 1) {
        if (t >= Tseq - 3) oconv[((size_t)b * 3 + (t - (Tseq - 3))) * 1024 + gch] = v3;
      }
    }
  }
  __syncthreads();

  {
    const int wm = wave >> 1, wn = wave & 1, lr = lane & 31, lh = lane >> 5;
    f32x16 aR, aI;
#pragma unroll
    for (int e = 0; e < 16; ++e) { aR[e] = 0.f; aI[e] = 0.f; }
#pragma unroll
    for (int ks = 0; ks < 4; ++ks) {
      bf16x8_t af = *(const bf16x8_t*)(sA + (wm * 32 + lr) * 72 + ks * 16 + lh * 8);
      bf16x8_t b1 = *(const bf16x8_t*)(sWa + (wn * 32 + lr) * 72 + ks * 16 + lh * 8);
      bf16x8_t b2 = *(const bf16x8_t*)(sWx + (wn * 32 + lr) * 72 + ks * 16 + lh * 8);
      aR = __builtin_amdgcn_mfma_f32_32x32x16_bf16(af, b1, aR, 0, 0, 0);
      aI = __builtin_amdgcn_mfma_f32_32x32x16_bf16(af, b2, aI, 0, 0, 0);
    }
    int col = wn * 32 + lr;
    float ba = (p.in[14] + oz)[la * 1024 + ch0 + col], bx = (p.in[16] + oz)[la * 1024 + ch0 + col];
#pragma unroll
    for (int e = 0; e < 16; ++e) {
      int row = wm * 32 + (e & 3) + 8 * (e >> 2) + 4 * lh;
      sR[row * 64 + col] = sigm(aR[e] + ba);
      sI[row * 64 + col] = sigm(aI[e] + bx);
    }
  }
  __syncthreads();

  float av[16], bv[16];
  bf16_t* HL = (bf16_t*)((p.ws + oz) + LA_OFF);
  bf16_t* PC = (bf16_t*)((p.ws + oz) + LB_OFF);
  {
    float sp = softplusf(-(p.in[17] + oz)[la * 1024 + gch]);
#pragma unroll
    for (int i = 0; i < 16; ++i) {
      int m = s * 16 + i;
      float rr = sR[m * 64 + c], ii = sI[m * 64 + c];
      float a = __expf(-8.f * rr * sp);
      av[i] = a;
      bv[i] = __builtin_amdgcn_sqrtf(fmaxf(1.f - a * a, 0.f)) * ii * xc[i];
    }
  }
  if (isP) {
    float P = 1.f, H = 0.f;
#pragma unroll
    for (int i = 0; i < 16; ++i) { H = av[i] * H + bv[i]; P *= av[i]; }
    sSeg[(s * 64 + c) * 2] = P; sSeg[(s * 64 + c) * 2 + 1] = H;
    __syncthreads();
    float h = 0.f, pc = 1.f;
    for (int q = 0; q < s; ++q) {
      float Pq = sSeg[(q * 64 + c) * 2], Hq = sSeg[(q * 64 + c) * 2 + 1];
      h = Pq * h + Hq; pc *= Pq;
    }
#pragma unroll
    for (int i = 0; i < 16; ++i) {
      const size_t o = (size_t)(r0 + s * 16 + i) * 1024 + gch;
      h = av[i] * h + bv[i]; pc *= av[i];
      HL[o] = f2bf(h); PC[o] = f2bf(pc);
    }
    if (s == 3) {
      const int b = tt >> 5, ti = tt & 31;
      float* summ = (float*)((p.ws + oz) + SUMM_OFF);
      size_t o = (((size_t)b * 32 + ti) * 1024 + gch) * 2;
      summ[o] = pc; summ[o + 1] = h;
    }
  } else {
    const float* hst = (p.in[3] + oz) + (size_t)la * 128 * 1024;
    float h = 0.f;
#pragma unroll
    for (int i = 0; i < 16; ++i) {
      const int row = r0 + s * 16 + i;
      const int bs = (row - MP) >> 2;
      if ((i & 3) == 0) h = hst[(size_t)bs * 1024 + gch];
      h = av[i] * h + bv[i];
      HL[(size_t)row * 1024 + gch] = f2bf(h); PC[(size_t)row * 1024 + gch] = 0;
      if ((i & 3) == 3) (p.out + oz)[O_LRUHS + ((size_t)la * 128 + bs) * 1024 + gch] = h;
    }
  }
  __syncthreads();
}

__device__ __forceinline__ void phase_lru_carry(const Params& p, int la) {
  const int oz = opaque_zero();
  const float* summ = (const float*)((p.ws + oz) + SUMM_OFF);
  float* carry = (float*)((p.ws + oz) + BONUS_OFF);
  for (int g = ((int)blockIdx.x + oz) * NTHREADS + ((int)threadIdx.x + oz); g < 8192; g += gridDim.x * NTHREADS) {
    const int b = g >> 10, ch = g & 1023;
    float2 ph[32];
#pragma unroll
    for (int tp = 0; tp < 32; ++tp) ph[tp] = *(const float2*)(summ + (((size_t)b * 32 + tp) * 1024 + ch) * 2);
    float h = 0.f;
#pragma unroll
    for (int tp = 0; tp < 32; ++tp) { carry[((size_t)b * 32 + tp) * 1024 + ch] = h; h = ph[tp].x * h + ph[tp].y; }
    (p.out + oz)[O_LRUHP + ((size_t)la * 8 + b) * 1024 + ch] = h;
  }
}

__device__ __forceinline__ void phase_lru_light(const Params& p) {
  const int oz = opaque_zero();
  const int lane = ((int)threadIdx.x + oz) & 63;
  const int gw = ((int)blockIdx.x + oz) * 4 + (((int)threadIdx.x + oz) >> 6), nw = gridDim.x * 4;
  const bf16_t* U = (const bf16_t*)((p.ws + oz) + U_OFF);
  const bf16_t* HL = (const bf16_t*)((p.ws + oz) + LA_OFF);
  const bf16_t* PC = (const bf16_t*)((p.ws + oz) + LB_OFF);
  bf16_t* A2 = (bf16_t*)((p.ws + oz) + R_OFF);
  const float* carry = (const float*)((p.ws + oz) + BONUS_OFF);
  for (int r2 = gw * 2; r2 < MT; r2 += nw * 2) {
    const bool isP = r2 < MP;
    const float* cbase = carry + ((size_t)(r2 >> 11) * 32 + ((r2 >> 6) & 31)) * 1024;
    u32x2 hl[2][4], pc[2][4], gt[2][4];
    float4 cin[4];
#pragma unroll
    for (int q = 0; q < 4; ++q) {
      const int c4 = (q * 64 + lane) * 4;
      cin[q] = make_float4(0.f, 0.f, 0.f, 0.f);
      if (isP) cin[q] = *(const float4*)(cbase + c4);
#pragma unroll
      for (int r = 0; r < 2; ++r) {
        const size_t row = (size_t)(r2 + r);
        hl[r][q] = *(const u32x2*)(HL + row * 1024 + c4);
        pc[r][q] = *(const u32x2*)(PC + row * 1024 + c4);
        gt[r][q] = *(const u32x2*)(U + row * 2048 + 1024 + c4);
      }
    }
#pragma unroll
    for (int q = 0; q < 4; ++q) {
      const int c4 = (q * 64 + lane) * 4;
#pragma unroll
      for (int r = 0; r < 2; ++r) {
        float h0 = bflo(hl[r][q].x) + bflo(pc[r][q].x) * cin[q].x, h1 = bfhi(hl[r][q].x) + bfhi(pc[r][q].x) * cin[q].y;
        float h2 = bflo(hl[r][q].y) + bflo(pc[r][q].y) * cin[q].z, h3 = bfhi(hl[r][q].y) + bfhi(pc[r][q].y) * cin[q].w;
        u32x2 w;
        w.x = pack2(h0 * siluf(bflo(gt[r][q].x)), h1 * siluf(bfhi(gt[r][q].x)));
        w.y = pack2(h2 * siluf(bflo(gt[r][q].y)), h3 * siluf(bfhi(gt[r][q].y)));
        *(u32x2*)(A2 + (size_t)(r2 + r) * 1024 + c4) = w;
      }
    }
  }
}

__device__ __forceinline__ void phase_lru_heavy(const Params& p, int la, char* smem) {
  const int oz = opaque_zero();
  for (int it = ((int)blockIdx.x + oz); it < 264 * 16; it += gridDim.x) lru_tile<1>(p, la, it >> 4, it & 15, smem);
}

#define REP_GCH 1
#define RW_SQ 8
#define REP_RPRE 1
#define REP_GPRE 1
#define RW_LDU 4352
__device__ __forceinline__ void rwkv_item(const Params& p, int row0, int T, bool isP, int b, int h, int sp0, int sp1, char* smem) {
  const int oz = opaque_zero();
  float* sRr = (float*)smem;
  float* sK = (float*)(smem + 8192);
  float* sW = (float*)(smem + 16384);
  float* sAp = (float*)(smem + 24576);
  float* sBp = (float*)(smem + 32768);
  float* sV = (float*)(smem + 40960);
  bf16_t* sL1 = (bf16_t*)(smem + 43008);
  bf16_t* sL2 = (bf16_t*)(smem + 47616);

  const int tid = ((int)threadIdx.x + oz), lane = tid & 63, wave = tid >> 6;
  const bf16_t* U = (const bf16_t*)((p.ws + oz) + U_OFF);
  const bf16_t* WT = (const bf16_t*)(p.ws + oz);
  bf16_t* rawy = (bf16_t*)((p.ws + oz) + R_OFF);
  float* bonus = (float*)((p.ws + oz) + BONUS_OFF);
  const int lr = lane & 31, lh = lane >> 5;

  bf16x8_t wf[4];
  {
    const bf16_t* wsrc = WT + ((wave < 2) ? W_RWW2T : W_RWA2T) + (size_t)(h * 64 + (wave & 1) * 32 + lr) * 64;
#pragma unroll
    for (int ks = 0; ks < 4; ++ks) wf[ks] = *(const bf16x8_t*)(wsrc + ks * 16 + lh * 8);
  }

  const int tok = tid >> 3, c8 = (tid & 7) * 8;
  const int irow = tid >> 4, cg4 = (tid & 15) * 4;
  const int vstride = isP ? 16 : 64;
  float* sCst = (float*)(smem + 52224);
  float* sY = (float*)(smem + 53504);
  if (tid < 64) {
    sCst[tid] = (p.in[24] + oz)[h * 64 + tid]; sCst[64 + tid] = (p.in[21] + oz)[h * 64 + tid];
    sCst[128 + tid] = (p.in[27] + oz)[h * 64 + tid]; sCst[192 + tid] = (p.in[28] + oz)[h * 64 + tid];
    sCst[256 + tid] = (p.in[29] + oz)[h * 64 + tid];
  }

  u32x4 pr, pk, pl1, pl2, pv;
  auto prefetch = [&](int t0) __attribute__((always_inline)) {
    int t = t0 + tok;
    pr = mk_u4(0, 0, 0, 0); pk = pr; pl1 = pr; pl2 = pr; pv = pr;
    if (t < T) {
      const bf16_t* u = U + (size_t)(row0 + t) * RW_LDU;
      pr = *(const u32x4*)(u + h * 64 + c8);
      pk = *(const u32x4*)(u + 1024 + h * 64 + c8);
      pl1 = *(const u32x4*)(u + 4096 + c8);
      pl2 = *(const u32x4*)(u + 4224 + c8);
    }
    if (isP) {
      if (tid < 64) {
        int tv = t0 + (tid >> 1);
        if (tv < T) pv = *(const u32x4*)(U + (size_t)(row0 + tv) * RW_LDU + 2048 + h * 64 + sp0 * 16 + (tid & 1) * 8);
      }
    } else {
      if (tid < 32) {
        int tv = t0 + (tid >> 3);
        if (tv < T) pv = *(const u32x4*)(U + (size_t)(row0 + tv) * RW_LDU + 2048 + h * 64 + (tid & 7) * 8);
      }
    }
  };

  float S[4] = {0.f, 0.f, 0.f, 0.f};
  prefetch(0);
  for (int t0 = 0; t0 < T; t0 += 32) {
    const int ntok = min(32, T - t0);
    for (int prep = 0; prep < REP_RPRE; ++prep) {
    {
      float f[8];
      unpack8(pr, f);
#pragma unroll
      for (int e = 0; e < 8; ++e) sRr[tok * 64 + c8 + e] = f[e];
      unpack8(pk, f);
#pragma unroll
      for (int e = 0; e < 8; ++e) sK[tok * 64 + c8 + e] = f[e];
      unpack8(pl1, f);
      u32x4 q;
      q.x = pack2(ftanh(f[0]), ftanh(f[1])); q.y = pack2(ftanh(f[2]), ftanh(f[3]));
      q.z = pack2(ftanh(f[4]), ftanh(f[5])); q.w = pack2(ftanh(f[6]), ftanh(f[7]));
      *(u32x4*)(sL1 + tok * 72 + c8) = q;
      *(u32x4*)(sL2 + tok * 72 + c8) = pl2;
      unpack8(pv, f);
      if (isP) {
        if (tid < 64) {
#pragma unroll
          for (int e = 0; e < 8; ++e) sV[(tid >> 1) * 16 + (tid & 1) * 8 + e] = f[e];
        }
      } else {
        if (tid < 32) {
#pragma unroll
          for (int e = 0; e < 8; ++e) sV[(tid >> 3) * 64 + (tid & 7) * 8 + e] = f[e];
        }
      }
    }
    __syncthreads();
    {
      f32x16 a;
#pragma unroll
      for (int e = 0; e < 16; ++e) a[e] = 0.f;
      const bf16_t* sL = (wave < 2) ? sL1 : sL2;
#pragma unroll
      for (int ks = 0; ks < 4; ++ks) {
        bf16x8_t af = *(const bf16x8_t*)(sL + lr * 72 + ks * 16 + lh * 8);
        a = __builtin_amdgcn_mfma_f32_32x32x16_bf16(af, wf[ks], a, 0, 0, 0);
      }
      float* dstp = (wave < 2) ? sW : sBp;
      int col = (wave & 1) * 32 + lr;
#pragma unroll
      for (int e = 0; e < 16; ++e) {
        int trow = (e & 3) + 8 * (e >> 2) + 4 * lh;
        dstp[trow * 64 + col] = a[e];
      }
    }
    __syncthreads();
    {
      const int gc = h * 64 + c8;
      float kkv[8], av8[8], kh8[8];
      float ssq = 0.f, bon = 0.f;
#pragma unroll
      for (int e = 0; e < 8; ++e) {
        int ch = gc + e;
        float kraw = sK[tok * 64 + c8 + e];
        float rr = sRr[tok * 64 + c8 + e];
        float aval = sigm(sCst[c8 + e] + sBp[tok * 64 + c8 + e]);
        float wv = __expf(-0.6065306597126334f * sigm(sCst[64 + c8 + e] + sW[tok * 64 + c8 + e]));
        float kq = kraw * sCst[128 + c8 + e];
        ssq += kq * kq;
        float kh = kraw * (1.f + (aval - 1.f) * sCst[192 + c8 + e]);
        bon += rr * kh * sCst[256 + c8 + e];
        kkv[e] = kq; av8[e] = aval; kh8[e] = kh;
        sW[tok * 64 + c8 + e] = wv;
      }
      ssq = sum8(ssq); bon = sum8(bon);
      float inv = rsqrtf(ssq + 1e-12f);
#pragma unroll
      for (int e = 0; e < 8; ++e) {
        float kk = kkv[e] * inv;
        sAp[tok * 64 + c8 + e] = -kk;
        sBp[tok * 64 + c8 + e] = kk * av8[e];
        sK[tok * 64 + c8 + e] = kh8[e];
      }
      if (sp0 == 0 && (tid & 7) == 0 && tok < ntok) bonus[(size_t)(row0 + t0 + tok) * 16 + h] = bon;
    }
    __syncthreads();
    }
    if (t0 + 32 < T) prefetch(t0 + 32);
    for (int sp = sp0; sp < sp1; ++sp) {
      if (!isP) {
        float4 s0 = *(const float4*)((p.in[5] + oz) + (((size_t)b * 16 + h) * 64 + sp * 16 + irow) * 64 + cg4);
        S[0] = s0.x; S[1] = s0.y; S[2] = s0.z; S[3] = s0.w;
      }
      const int voff = isP ? irow : (sp * 16 + irow);
      f32x2 Sa, Sb;
      Sa.x = S[0]; Sa.y = S[1]; Sb.x = S[2]; Sb.y = S[3];
      for (int t = 0; t < ntok; ++t) {
        const f32x4 a4 = *(const f32x4*)(sAp + t * 64 + cg4);
        const f32x4 w4 = *(const f32x4*)(sW + t * 64 + cg4);
        const f32x4 b4 = *(const f32x4*)(sBp + t * 64 + cg4);
        const f32x4 k4 = *(const f32x4*)(sK + t * 64 + cg4);
        const f32x4 r4 = *(const f32x4*)(sRr + t * 64 + cg4);
        const float vv = sV[t * vstride + voff];
        f32x2 sav = Sa * a4.xy + Sb * a4.zw;
        const float sa = sum16(sav.x + sav.y);
        f32x2 sa2; sa2.x = sa; sa2.y = sa;
        f32x2 vv2; vv2.x = vv; vv2.y = vv;
        Sa = Sa * w4.xy + (sa2 * b4.xy + vv2 * k4.xy);
        Sb = Sb * w4.zw + (sa2 * b4.zw + vv2 * k4.zw);
        f32x2 yv = Sa * r4.xy + Sb * r4.zw;
        const float y = sum16(yv.x + yv.y);
        if ((tid & 15) == 0) rawy[(size_t)(row0 + t0 + t) * 1024 + h * 64 + sp * 16 + irow] = f2bf(y);
      }
      S[0] = Sa.x; S[1] = Sa.y; S[2] = Sb.x; S[3] = Sb.y;
      if (!isP) {
        *(float4*)((p.out + oz) + O_WKVS + (((size_t)b * 16 + h) * 64 + sp * 16 + irow) * 64 + cg4) = make_float4(S[0], S[1], S[2], S[3]);
      }
    }
    __syncthreads();
  }
  if (isP) {
    *(float4*)((p.out + oz) + O_WKVP + (((size_t)b * 16 + h) * 64 + sp0 * 16 + irow) * 64 + cg4) = make_float4(S[0], S[1], S[2], S[3]);
  }
}


#define RX_OFF (R_OFF + (size_t)34603008)
__device__ __forceinline__ void rwkv_pre_tile(const Params& p, int tile, char* smem) {
  const int oz = opaque_zero();
  float* sRr = (float*)smem;
  float* sK = (float*)(smem + 8192);
  float* sW = (float*)(smem + 16384);
  float* sBp = (float*)(smem + 24576);
  bf16_t* sL1 = (bf16_t*)(smem + 32768);
  bf16_t* sL2 = (bf16_t*)(smem + 37376);
  float* sCst = (float*)(smem + 41984);
  const int tid = ((int)threadIdx.x + oz), lane = tid & 63, wave = tid >> 6;
  bf16_t* U = (bf16_t*)((p.ws + oz) + U_OFF);
  const bf16_t* WT = (const bf16_t*)(p.ws + oz);
  bf16_t* X = (bf16_t*)((p.ws + oz) + RX_OFF);
  bf16_t* AP = (bf16_t*)((p.out + oz) + O_GSS);
  bf16_t* BP = AP + (size_t)MP * 1024;
  float* bonus = (float*)((p.ws + oz) + BONUS_OFF);
  const int lr = lane & 31, lh = lane >> 5;
  const int tok = tid >> 3, c8 = (tid & 7) * 8;
  const int row = tile * 32 + tok;
  bf16_t* u = U + (size_t)row * RW_LDU;
  {
    float f[8];
    unpack8(*(const u32x4*)(u + 4096 + c8), f);
    u32x4 q;
    q.x = pack2(ftanh(f[0]), ftanh(f[1])); q.y = pack2(ftanh(f[2]), ftanh(f[3]));
    q.z = pack2(ftanh(f[4]), ftanh(f[5])); q.w = pack2(ftanh(f[6]), ftanh(f[7]));
    *(u32x4*)(sL1 + tok * 72 + c8) = q;
    *(u32x4*)(sL2 + tok * 72 + c8) = *(const u32x4*)(u + 4224 + c8);
  }
  u32x4 pr, pk; bf16x8_t wf[4]; float cst[5] = {0.f, 0.f, 0.f, 0.f, 0.f};
  auto prefetch = [&](int h) __attribute__((always_inline)) {
    pr = *(const u32x4*)(u + h * 64 + c8);
    pk = *(const u32x4*)(u + 1024 + h * 64 + c8);
    const bf16_t* wsrc = WT + ((wave < 2) ? W_RWW2T : W_RWA2T) + (size_t)(h * 64 + (wave & 1) * 32 + lr) * 64;
#pragma unroll
    for (int ks = 0; ks < 4; ++ks) wf[ks] = *(const bf16x8_t*)(wsrc + ks * 16 + lh * 8);
    if (tid < 64) {
      cst[0] = (p.in[24] + oz)[h * 64 + tid]; cst[1] = (p.in[21] + oz)[h * 64 + tid]; cst[2] = (p.in[27] + oz)[h * 64 + tid];
      cst[3] = (p.in[28] + oz)[h * 64 + tid]; cst[4] = (p.in[29] + oz)[h * 64 + tid];
    }
  };
  prefetch(0);
  for (int h = 0; h < 16; ++h) {
    {
      float f[8];
      unpack8(pr, f);
#pragma unroll
      for (int e = 0; e < 8; ++e) sRr[tok * 64 + c8 + e] = f[e];
      unpack8(pk, f);
#pragma unroll
      for (int e = 0; e < 8; ++e) sK[tok * 64 + c8 + e] = f[e];
      if (tid < 64) {
#pragma unroll
        for (int q = 0; q < 5; ++q) sCst[q * 64 + tid] = cst[q];
      }
    }
    __syncthreads();
    {
      f32x16 a;
#pragma unroll
      for (int e = 0; e < 16; ++e) a[e] = 0.f;
      const bf16_t* sL = (wave < 2) ? sL1 : sL2;
#pragma unroll
      for (int ks = 0; ks < 4; ++ks) {
        bf16x8_t af = *(const bf16x8_t*)(sL + lr * 72 + ks * 16 + lh * 8);
        a = __builtin_amdgcn_mfma_f32_32x32x16_bf16(af, wf[ks], a, 0, 0, 0);
      }
      float* dstp = (wave < 2) ? sW : sBp;
      int col = (wave & 1) * 32 + lr;
#pragma unroll
      for (int e = 0; e < 16; ++e) dstp[((e & 3) + 8 * (e >> 2) + 4 * lh) * 64 + col] = a[e];
    }
    if (h + 1 < 16) prefetch(h + 1);
    __syncthreads();
    {
      float kkv[8], av8[8], kh8[8], xx[8];
      float ssq = 0.f, bon = 0.f;
#pragma unroll
      for (int e = 0; e < 8; ++e) {
        float kraw = sK[tok * 64 + c8 + e];
        float rr = sRr[tok * 64 + c8 + e];
        float aval = sigm(sCst[c8 + e] + sBp[tok * 64 + c8 + e]);
        xx[e] = 0.6065306597126334f * sigm(sCst[64 + c8 + e] + sW[tok * 64 + c8 + e]);
        float kq = kraw * sCst[128 + c8 + e];
        ssq += kq * kq;
        float kh = kraw * (1.f + (aval - 1.f) * sCst[192 + c8 + e]);
        bon += rr * kh * sCst[256 + c8 + e];
        kkv[e] = kq; av8[e] = aval; kh8[e] = kh;
      }
      ssq = sum8(ssq); bon = sum8(bon);
      float inv = rsqrtf(ssq + 1e-12f);
      float ap[8], bp[8];
#pragma unroll
      for (int e = 0; e < 8; ++e) { float kk = kkv[e] * inv; ap[e] = -kk; bp[e] = kk * av8[e]; }
      const size_t o = (size_t)row * 1024 + h * 64 + c8;
      *(u32x4*)(X + o) = mk_u4(pack2(xx[0], xx[1]), pack2(xx[2], xx[3]), pack2(xx[4], xx[5]), pack2(xx[6], xx[7]));
      *(u32x4*)(AP + o) = mk_u4(pack2(ap[0], ap[1]), pack2(ap[2], ap[3]), pack2(ap[4], ap[5]), pack2(ap[6], ap[7]));
      *(u32x4*)(BP + o) = mk_u4(pack2(bp[0], bp[1]), pack2(bp[2], bp[3]), pack2(bp[4], bp[5]), pack2(bp[6], bp[7]));
      *(u32x4*)(u + 1024 + h * 64 + c8) = mk_u4(pack2(kh8[0], kh8[1]), pack2(kh8[2], kh8[3]), pack2(kh8[4], kh8[5]), pack2(kh8[6], kh8[7]));
      if ((tid & 7) == 0) bonus[(size_t)row * 16 + h] = bon;
    }
    __syncthreads();
  }
}
__device__ __forceinline__ void phase_rwkv_pre(const Params& p, char* smem) {
  const int oz = opaque_zero();
  for (int it = ((int)blockIdx.x + oz); it < 512; it += gridDim.x) rwkv_pre_tile(p, it, smem);
}

__device__ __forceinline__ void rwkv_prompt_item(const Params& p, int b, int h, int half, char* smem) {
  const int oz = opaque_zero();
  float* sRr = (float*)smem;
  float* sK = (float*)(smem + 8192);
  float* sW = (float*)(smem + 16384);
  float* sAp = (float*)(smem + 24576);
  float* sBp = (float*)(smem + 32768);
  float* sV = (float*)(smem + 40960);
  float* sY = (float*)(smem + 45056);
  const int tid = ((int)threadIdx.x + oz);
  const bf16_t* U = (const bf16_t*)((p.ws + oz) + U_OFF);
  const bf16_t* X = (const bf16_t*)((p.ws + oz) + RX_OFF);
  const bf16_t* AP = (const bf16_t*)((p.out + oz) + O_GSS);
  const bf16_t* BP = AP + (size_t)MP * 1024;
  bf16_t* rawy = (bf16_t*)((p.ws + oz) + R_OFF);
  const int row0 = b * 2048;
  const int tok = tid >> 3, c8 = (tid & 7) * 8;
  const int irow = tid >> 3;
  u32x4 pr, pk, px, pa, pb, pv;
  auto prefetch = [&](int t0) __attribute__((always_inline)) {
    const size_t row = (size_t)(row0 + t0 + tok);
    pr = *(const u32x4*)(U + row * RW_LDU + h * 64 + c8);
    pk = *(const u32x4*)(U + row * RW_LDU + 1024 + h * 64 + c8);
    px = *(const u32x4*)(X + row * 1024 + h * 64 + c8);
    pa = *(const u32x4*)(AP + row * 1024 + h * 64 + c8);
    pb = *(const u32x4*)(BP + row * 1024 + h * 64 + c8);
    pv = *(const u32x4*)(U + (size_t)(row0 + t0 + ((tid & 127) >> 2)) * RW_LDU + 2048 + h * 64 + half * 32 + (tid & 3) * 8);
  };
  f32x2 S0, S1, S2, S3;
  S0.x = 0.f; S0.y = 0.f; S1 = S0; S2 = S0; S3 = S0;
  prefetch(0);
  for (int t0 = 0; t0 < 2048; t0 += 32) {
    {
      float f[8];
      unpack8(pr, f);
      *(float4*)(sRr + tok * 64 + c8) = make_float4(f[0], f[1], f[2], f[3]); *(float4*)(sRr + tok * 64 + c8 + 4) = make_float4(f[4], f[5], f[6], f[7]);
      unpack8(pk, f);
      *(float4*)(sK + tok * 64 + c8) = make_float4(f[0], f[1], f[2], f[3]); *(float4*)(sK + tok * 64 + c8 + 4) = make_float4(f[4], f[5], f[6], f[7]);
      unpack8(px, f);
      *(float4*)(sW + tok * 64 + c8) = make_float4(__expf(-f[0]), __expf(-f[1]), __expf(-f[2]), __expf(-f[3]));
      *(float4*)(sW + tok * 64 + c8 + 4) = make_float4(__expf(-f[4]), __expf(-f[5]), __expf(-f[6]), __expf(-f[7]));
      unpack8(pa, f);
      *(float4*)(sAp + tok * 64 + c8) = make_float4(f[0], f[1], f[2], f[3]); *(float4*)(sAp + tok * 64 + c8 + 4) = make_float4(f[4], f[5], f[6], f[7]);
      unpack8(pb, f);
      *(float4*)(sBp + tok * 64 + c8) = make_float4(f[0], f[1], f[2], f[3]); *(float4*)(sBp + tok * 64 + c8 + 4) = make_float4(f[4], f[5], f[6], f[7]);
      unpack8(pv, f);
      float* d = sV + ((tid & 127) >> 2) * 32 + (tid & 3) * 8;
      *(float4*)d = make_float4(f[0], f[1], f[2], f[3]); *(float4*)(d + 4) = make_float4(f[4], f[5], f[6], f[7]);
    }
    __syncthreads();
    if (t0 > 0) {
      const float* sYp = sY + (((t0 >> 5) + 1) & 1) * 1024;
      const int ty = tid >> 3, i4 = (tid & 7) * 4;
      u32x2 w; w.x = pack2(sYp[ty * 32 + i4], sYp[ty * 32 + i4 + 1]); w.y = pack2(sYp[ty * 32 + i4 + 2], sYp[ty * 32 + i4 + 3]);
      *(u32x2*)(rawy + (size_t)(row0 + t0 - 32 + ty) * 1024 + h * 64 + half * 32 + i4) = w;
    }
    if (t0 + 32 < 2048) prefetch(t0 + 32);
    float* sYc = sY + ((t0 >> 5) & 1) * 1024;
    f32x4 a0 = *(const f32x4*)(sAp + c8), a1 = *(const f32x4*)(sAp + c8 + 4);
    f32x4 w0 = *(const f32x4*)(sW + c8), w1 = *(const f32x4*)(sW + c8 + 4);
    f32x4 b0 = *(const f32x4*)(sBp + c8), b1 = *(const f32x4*)(sBp + c8 + 4);
    f32x4 k0 = *(const f32x4*)(sK + c8), k1 = *(const f32x4*)(sK + c8 + 4);
    f32x4 r0 = *(const f32x4*)(sRr + c8), r1 = *(const f32x4*)(sRr + c8 + 4);
    float vv = sV[irow];
#pragma unroll 2
    for (int t = 0; t < 32; ++t) {
      const int tn = (t + 1) & 31;
      const f32x4 na0 = *(const f32x4*)(sAp + tn * 64 + c8), na1 = *(const f32x4*)(sAp + tn * 64 + c8 + 4);
      const f32x4 nw0 = *(const f32x4*)(sW + tn * 64 + c8), nw1 = *(const f32x4*)(sW + tn * 64 + c8 + 4);
      const f32x4 nb0 = *(const f32x4*)(sBp + tn * 64 + c8), nb1 = *(const f32x4*)(sBp + tn * 64 + c8 + 4);
      const f32x4 nk0 = *(const f32x4*)(sK + tn * 64 + c8), nk1 = *(const f32x4*)(sK + tn * 64 + c8 + 4);
      const f32x4 nr0 = *(const f32x4*)(sRr + tn * 64 + c8), nr1 = *(const f32x4*)(sRr + tn * 64 + c8 + 4);
      const float nv = sV[tn * 32 + irow];
      f32x2 sav = (S0 * a0.xy + S1 * a0.zw) + (S2 * a1.xy + S3 * a1.zw);
      const float sa = sum8(sav.x + sav.y);
      f32x2 sa2; sa2.x = sa; sa2.y = sa;
      f32x2 vv2; vv2.x = vv; vv2.y = vv;
      S0 = S0 * w0.xy + (sa2 * b0.xy + vv2 * k0.xy);
      S1 = S1 * w0.zw + (sa2 * b0.zw + vv2 * k0.zw);
      S2 = S2 * w1.xy + (sa2 * b1.xy + vv2 * k1.xy);
      S3 = S3 * w1.zw + (sa2 * b1.zw + vv2 * k1.zw);
      f32x2 yv = (S0 * r0.xy + S1 * r0.zw) + (S2 * r1.xy + S3 * r1.zw);
      const float y = sum8(yv.x + yv.y);
      sYc[t * 32 + irow] = y;
      a0 = na0; a1 = na1; w0 = nw0; w1 = nw1; b0 = nb0; b1 = nb1; k0 = nk0; k1 = nk1; r0 = nr0; r1 = nr1; vv = nv;
    }
    __syncthreads();
  }
  {
    const float* sYp = sY + 1024;
    const int ty = tid >> 3, i4 = (tid & 7) * 4;
    u32x2 w; w.x = pack2(sYp[ty * 32 + i4], sYp[ty * 32 + i4 + 1]); w.y = pack2(sYp[ty * 32 + i4 + 2], sYp[ty * 32 + i4 + 3]);
    *(u32x2*)(rawy + (size_t)(row0 + 2048 - 32 + ty) * 1024 + h * 64 + half * 32 + i4) = w;
  }
  {
    float* so = (p.out + oz) + O_WKVP + (((size_t)b * 16 + h) * 64 + half * 32 + irow) * 64 + c8;
    *(float4*)so = make_float4(S0.x, S0.y, S1.x, S1.y);
    *(float4*)(so + 4) = make_float4(S2.x, S2.y, S3.x, S3.y);
  }
  __syncthreads();
}

__device__ __forceinline__ void phase_rwkv_scan(const Params& p, char* smem) {
  const int oz = opaque_zero();
  const int bid = ((int)blockIdx.x + oz), G = gridDim.x;
  const int xcd = bid & 7, local = bid >> 3;
  const bool even_ok = (G == 512);
  if (even_ok) {
    if (bid < 256) {
      const int it = bid;
      rwkv_prompt_item(p, it >> 5, (it >> 1) & 15, it & 1, smem);
      for (int j = RW_SQ * 256 + bid; j < 2048; j += 256) rwkv_item(p, MP + (j >> 4) * 4, 4, false, j >> 4, j & 15, 0, 4, smem);
    } else {
      const int sidx = bid - 256;
      for (int j = sidx; j < RW_SQ * 256; j += 256) rwkv_item(p, MP + (j >> 4) * 4, 4, false, j >> 4, j & 15, 0, 4, smem);
    }
  } else {
    for (int it = bid; it < 256 + 2048; it += G) {
      if (it < 256) rwkv_prompt_item(p, it >> 5, (it >> 1) & 15, it & 1, smem);
      else { const int j = it - 256; rwkv_item(p, MP + (j >> 4) * 4, 4, false, j >> 4, j & 15, 0, 4, smem); }
    }
  }
}

__device__ __forceinline__ void phase_rwkv_post(const Params& p, const XSrc x1) {
  const int oz = opaque_zero();
  const int lane = ((int)threadIdx.x + oz) & 63;
  const int gw = ((int)blockIdx.x + oz) * 4 + (((int)threadIdx.x + oz) >> 6), nw = gridDim.x * 4;
  bf16_t* U = (bf16_t*)((p.ws + oz) + U_OFF);
  const bf16_t* rawy = (const bf16_t*)((p.ws + oz) + R_OFF);
  const float* bonus = (const float*)((p.ws + oz) + BONUS_OFF);
  const int ch = lane * 16;
  float gng[16], gnb[16];
#pragma unroll
  for (int e = 0; e < 16; ++e) { gng[e] = (p.in[30] + oz)[ch + e]; gnb[e] = (p.in[31] + oz)[ch + e]; }
  for (int row = gw; row < MT; row += nw) {
    float y[16];
    unpack8(*(const u32x4*)(rawy + (size_t)row * 1024 + ch), y);
    unpack8(*(const u32x4*)(rawy + (size_t)row * 1024 + ch + 8), y + 8);
    float s = 0.f;
#pragma unroll
    for (int e = 0; e < 16; ++e) s += y[e];
    s = sum4(s);
    float m = s * (1.f / 64.f);
    float q2 = 0.f;
#pragma unroll
    for (int e = 0; e < 16; ++e) { float d = y[e] - m; q2 += d * d; }
    q2 = sum4(q2);
    float rs = rsqrtf(q2 * (1.f / 64.f) + 64e-5f);
    float bon = bonus[(size_t)row * 16 + (lane >> 2)];
    bf16_t* u = U + (size_t)row * RW_LDU;
    float vf[16], gf[16];
    unpack8(*(const u32x4*)(u + 2048 + ch), vf); unpack8(*(const u32x4*)(u + 2048 + ch + 8), vf + 8);
    unpack8(*(const u32x4*)(u + 3072 + ch), gf); unpack8(*(const u32x4*)(u + 3072 + ch + 8), gf + 8);
    unsigned w[8];
#pragma unroll
    for (int e = 0; e < 8; ++e) {
      float o0 = (y[2 * e] - m) * rs * gng[2 * e] + gnb[2 * e] + bon * vf[2 * e];
      float o1 = (y[2 * e + 1] - m) * rs * gng[2 * e + 1] + gnb[2 * e + 1] + bon * vf[2 * e + 1];
      w[e] = pack2(o0 * siluf(gf[2 * e]), o1 * siluf(gf[2 * e + 1]));
    }
    *(u32x4*)(u + ch) = mk_u4(w[0], w[1], w[2], w[3]);
    *(u32x4*)(u + ch + 8) = mk_u4(w[4], w[5], w[6], w[7]);
  }
  for (int sq = gw; sq < 136; sq += nw) {
    int row = sq < 8 ? sq * 2048 + 2047 : MP + (sq - 8) * 4 + 3;
    float mu, rs;
    row_stats(x1.stats, row, mu, rs);
    const float* z = xrow(x1, row);
    float* o = (p.out + oz) + (sq < 8 ? O_SHIFTP + (size_t)sq * 1024 : O_SHIFTS + (size_t)(sq - 8) * 1024);
#pragma unroll
    for (int e = 0; e < 16; ++e) o[ch + e] = (z[ch + e] - mu) * rs * x1.g[ch + e] + x1.b[ch + e];
  }
}

#define GD_LDU 3200
#define GQK_OFF ((size_t)141688832)
#define GVV_OFF (R_OFF + (size_t)34603008)
#define GSC_OFF SUMM_OFF
__device__ __forceinline__ void gdn_pre_tile(const Params& p, int tt) {
  const int oz = opaque_zero();
  const int tid = ((int)threadIdx.x + oz);
  const bf16_t* U = (const bf16_t*)((p.ws + oz) + U_OFF);
  bf16_t* QK = (bf16_t*)((p.ws + oz) + GQK_OFF);
  bf16_t* VV = (bf16_t*)((p.ws + oz) + GVV_OFF);
  float* SC = (float*)((p.ws + oz) + GSC_OFF);
  const int r0 = tt * 32;
  const bool isP = r0 < MP;
  const int Tseq = isP ? 2048 : 4;
  const int c8 = tid * 8;
  float cw[4][8];
#pragma unroll
  for (int j = 0; j < 4; ++j) {
    float4 a = *(const float4*)((p.in[34] + oz) + j * 2048 + c8), c = *(const float4*)((p.in[34] + oz) + j * 2048 + c8 + 4);
    cw[j][0] = a.x; cw[j][1] = a.y; cw[j][2] = a.z; cw[j][3] = a.w; cw[j][4] = c.x; cw[j][5] = c.y; cw[j][6] = c.z; cw[j][7] = c.w;
  }
  float w0[8], w1[8], w2[8];
#pragma unroll
  for (int e = 0; e < 8; ++e) { w0[e] = 0.f; w1[e] = 0.f; w2[e] = 0.f; }
  for (int mb = 0; mb < 32; mb += 16) {
    u32x4 rw[16];
#pragma unroll
    for (int i = 0; i < 16; ++i) rw[i] = *(const u32x4*)(U + (size_t)(r0 + mb + i) * GD_LDU + c8);
#pragma unroll
    for (int i = 0; i < 16; ++i) {
    const int m = mb + i;
    const int row = r0 + m;
    int t, b;
    if (isP) { t = row & 2047; b = row >> 11; } else { t = (row - MP) & 3; b = (row - MP) >> 2; }
    if (t == 0) {
      if (isP) {
#pragma unroll
        for (int e = 0; e < 8; ++e) { w0[e] = 0.f; w1[e] = 0.f; w2[e] = 0.f; }
      } else {
        const float* st = (p.in[6] + oz) + (size_t)b * 3 * 2048 + c8;
        float4 a, c;
        a = *(const float4*)(st); c = *(const float4*)(st + 4);
        w0[0] = a.x; w0[1] = a.y; w0[2] = a.z; w0[3] = a.w; w0[4] = c.x; w0[5] = c.y; w0[6] = c.z; w0[7] = c.w;
        a = *(const float4*)(st + 2048); c = *(const float4*)(st + 2048 + 4);
        w1[0] = a.x; w1[1] = a.y; w1[2] = a.z; w1[3] = a.w; w1[4] = c.x; w1[5] = c.y; w1[6] = c.z; w1[7] = c.w;
        a = *(const float4*)(st + 4096); c = *(const float4*)(st + 4096 + 4);
        w2[0] = a.x; w2[1] = a.y; w2[2] = a.z; w2[3] = a.w; w2[4] = c.x; w2[5] = c.y; w2[6] = c.z; w2[7] = c.w;
      }
    } else if (m == 0) {
      unpack8(*(const u32x4*)(U + (size_t)(row - 3) * GD_LDU + c8), w0);
      unpack8(*(const u32x4*)(U + (size_t)(row - 2) * GD_LDU + c8), w1);
      unpack8(*(const u32x4*)(U + (size_t)(row - 1) * GD_LDU + c8), w2);
    }
    float w3[8];
    unpack8(rw[i], w3);
    float x[8];
    float ssq = 0.f;
#pragma unroll
    for (int e = 0; e < 8; ++e) {
      float v = cw[0][e] * w0[e] + cw[1][e] * w1[e] + cw[2][e] * w2[e] + cw[3][e] * w3[e];
      v = siluf(v);
      x[e] = v; ssq += v * v;
    }
    if (t >= Tseq - 3) {
      float* o = (p.out + oz) + (isP ? O_GCONVP : O_GCONVS) + ((size_t)b * 3 + (t - (Tseq - 3))) * 2048 + c8;
      *(float4*)o = make_float4(w3[0], w3[1], w3[2], w3[3]);
      *(float4*)(o + 4) = make_float4(w3[4], w3[5], w3[6], w3[7]);
    }
    if (tid < 128) {
      ssq = sum16(ssq);
      float sc = rsqrtf(ssq + 1e-6f) * ((tid < 64) ? 0.08838834764831845f : 1.f);
      *(u32x4*)(QK + (size_t)row * 1024 + c8) = mk_u4(pack2(x[0] * sc, x[1] * sc), pack2(x[2] * sc, x[3] * sc), pack2(x[4] * sc, x[5] * sc), pack2(x[6] * sc, x[7] * sc));
    } else {
      *(u32x4*)(VV + (size_t)row * 1024 + (c8 - 1024)) = mk_u4(pack2(x[0], x[1]), pack2(x[2], x[3]), pack2(x[4], x[5]), pack2(x[6], x[7]));
    }
#pragma unroll
    for (int e = 0; e < 8; ++e) { w0[e] = w1[e]; w1[e] = w2[e]; w2[e] = w3[e]; }
    }
  }
  {
    const int m = tid >> 3, hv = tid & 7;
    const int row = r0 + m;
    float beta = sigm(bf2f(U[(size_t)row * GD_LDU + 3072 + hv]));
    float g = -expf((p.in[35] + oz)[hv]) * softplusf(bf2f(U[(size_t)row * GD_LDU + 3080 + hv]) + (p.in[36] + oz)[hv]);
    SC[(size_t)row * 32 + hv] = expf(g);
    SC[(size_t)row * 32 + 8 + hv] = beta;
    __shared__ float sGp[32 * 8];
    sGp[m * 8 + hv] = g;
    __syncthreads();
    float gc = 0.f;
    const int mb = m & 16;
#pragma unroll
    for (int j = 0; j < 16; ++j) gc += (mb + j <= m) ? sGp[(mb + j) * 8 + hv] : 0.f;
    SC[(size_t)row * 32 + 16 + hv] = gc;
    __syncthreads();
  }
}
__device__ __forceinline__ void phase_gdn_pre(const Params& p) {
  const int oz = opaque_zero();
  for (int it = ((int)blockIdx.x + oz); it < 528; it += gridDim.x) gdn_pre_tile(p, it);
}

__device__ __forceinline__ void gdn_item(const Params& p, int row0, int T, bool isP, int b, int hv, int sl0, int sl1, char* smem) {
  const int oz = opaque_zero();
  float* sQ = (float*)smem;
  float* sKk = (float*)(smem + 16384);
  float* sV = (float*)(smem + 32768);
  float* sSc = (float*)(smem + 34816);

  const int tid = ((int)threadIdx.x + oz);
  const bf16_t* QK = (const bf16_t*)((p.ws + oz) + GQK_OFF);
  const bf16_t* VV = (const bf16_t*)((p.ws + oz) + GVV_OFF);
  const float* SC = (const float*)((p.ws + oz) + GSC_OFF);
  bf16_t* rawo = (bf16_t*)((p.ws + oz) + R_OFF);
  const int hk = hv >> 1;
  const int vcols = isP ? 16 : 128;

  const int col = tid >> 4, kg8 = (tid & 15) * 8;
  float S[8];
#pragma unroll
  for (int e = 0; e < 8; ++e) S[e] = 0.f;

  u32x4 pq[2], pk[2], pvv; float pe = 0.f, pb = 0.f;
  auto prefetch = [&](int t0) __attribute__((always_inline)) {
#pragma unroll
    for (int i = 0; i < 2; ++i) {
      int idx = tid + 256 * i;
      int tok = idx >> 4, cc = (idx & 15) * 8;
      pq[i] = mk_u4(0, 0, 0, 0); pk[i] = pq[i];
      if (t0 + tok < T) {
        pq[i] = *(const u32x4*)(QK + (size_t)(row0 + t0 + tok) * 1024 + hk * 128 + cc);
        pk[i] = *(const u32x4*)(QK + (size_t)(row0 + t0 + tok) * 1024 + 512 + hk * 128 + cc);
      }
    }
    pvv = mk_u4(0, 0, 0, 0);
    if (tid < 64) {
      if (isP) { int tok = tid >> 1; if (t0 + tok < T) pvv = *(const u32x4*)(VV + (size_t)(row0 + t0 + tok) * 1024 + hv * 128 + sl0 * 16 + (tid & 1) * 8); }
      else { int tok = tid >> 4; if (t0 + tok < T) pvv = *(const u32x4*)(VV + (size_t)(row0 + t0 + tok) * 1024 + hv * 128 + (tid & 15) * 8); }
    }
    if (tid < 32) {
      pe = 1.f; pb = 0.f;
      if (t0 + tid < T) { pe = SC[(size_t)(row0 + t0 + tid) * 32 + hv]; pb = SC[(size_t)(row0 + t0 + tid) * 32 + 8 + hv]; }
    }
  };

  prefetch(0);
  for (int t0 = 0; t0 < T; t0 += 32) {
    const int ntok = min(32, T - t0);
#pragma unroll
    for (int i = 0; i < 2; ++i) {
      int idx = tid + 256 * i;
      int tok = idx >> 4, cc = (idx & 15) * 8;
      float f[8];
      unpack8(pq[i], f);
      *(float4*)(sQ + tok * 128 + cc) = make_float4(f[0], f[1], f[2], f[3]);
      *(float4*)(sQ + tok * 128 + cc + 4) = make_float4(f[4], f[5], f[6], f[7]);
      unpack8(pk[i], f);
      *(float4*)(sKk + tok * 128 + cc) = make_float4(f[0], f[1], f[2], f[3]);
      *(float4*)(sKk + tok * 128 + cc + 4) = make_float4(f[4], f[5], f[6], f[7]);
    }
    if (tid < 64) {
      float f[8];
      unpack8(pvv, f);
      float* d = isP ? (sV + (tid >> 1) * 16 + (tid & 1) * 8) : (sV + (tid >> 4) * 128 + (tid & 15) * 8);
      *(float4*)d = make_float4(f[0], f[1], f[2], f[3]);
      *(float4*)(d + 4) = make_float4(f[4], f[5], f[6], f[7]);
    }
    if (tid < 32) { sSc[tid * 4] = pe; sSc[tid * 4 + 1] = pb; }
    __syncthreads();
    {
      const int tok = tid >> 3, part = tid & 7;
      float d = 0.f;
#pragma unroll
      for (int e = 0; e < 16; ++e) d += sQ[tok * 128 + part * 16 + e] * sKk[tok * 128 + part * 16 + e];
      d = sum8(d);
      if (part == 0) sSc[tok * 4 + 2] = d;
    }
    __syncthreads();
    if (t0 + 32 < T) prefetch(t0 + 32);
    for (int sl = sl0; sl < sl1; ++sl) {
      const int vc = isP ? col : (sl * 16 + col);
      const size_t sbase = (((size_t)b * 8 + hv) * 128 + kg8) * 128 + sl * 16 + col;
      float* sS = (float*)(smem + 35328);
      if (!isP) {
        const size_t gb = (((size_t)b * 8 + hv) * 128) * 128 + sl * 16;
#pragma unroll
        for (int i = 0; i < 2; ++i) {
          int k = (tid >> 2) + 64 * i, c4 = (tid & 3) * 4;
          *(float4*)(sS + k * 16 + c4) = *(const float4*)((p.in[7] + oz) + gb + (size_t)k * 128 + c4);
        }
        __syncthreads();
#pragma unroll
        for (int e = 0; e < 8; ++e) S[e] = sS[(kg8 + e) * 16 + col];
      }
      f32x2 S2[4];
#pragma unroll
      for (int e = 0; e < 4; ++e) { S2[e].x = S[2 * e]; S2[e].y = S[2 * e + 1]; }
      for (int t = 0; t < ntok; ++t) {
        const f32x4 k0 = *(const f32x4*)(sKk + t * 128 + kg8), k1 = *(const f32x4*)(sKk + t * 128 + kg8 + 4);
        const f32x4 q0 = *(const f32x4*)(sQ + t * 128 + kg8), q1 = *(const f32x4*)(sQ + t * 128 + kg8 + 4);
        const f32x4 sc = *(const f32x4*)(sSc + t * 4);
        const float vv = sV[t * vcols + vc];
        const f32x2 ka = k0.xy, kb = k0.zw, kc = k1.xy, kd = k1.zw;
        const f32x2 qa = q0.xy, qb = q0.zw, qc = q1.xy, qd = q1.zw;
        f32x2 d1v = (S2[0] * ka + S2[1] * kb) + (S2[2] * kc + S2[3] * kd);
        f32x2 d2v = (S2[0] * qa + S2[1] * qb) + (S2[2] * qc + S2[3] * qd);
        float d1 = sum16(d1v.x + d1v.y);
        float d2 = sum16(d2v.x + d2v.y);
        const float eg = sc.x;
        const float vnew = sc.y * (vv - eg * d1);
        f32x2 eg2; eg2.x = eg; eg2.y = eg;
        f32x2 vn2; vn2.x = vnew; vn2.y = vnew;
        S2[0] = S2[0] * eg2 + ka * vn2; S2[1] = S2[1] * eg2 + kb * vn2;
        S2[2] = S2[2] * eg2 + kc * vn2; S2[3] = S2[3] * eg2 + kd * vn2;
        float o = eg * d2 + sc.z * vnew;
        if ((tid & 15) == 0) rawo[(size_t)(row0 + t0 + t) * 1024 + hv * 128 + sl * 16 + col] = f2bf(o);
      }
#pragma unroll
      for (int e = 0; e < 4; ++e) { S[2 * e] = S2[e].x; S[2 * e + 1] = S2[e].y; }
      if (!isP) {
        const size_t gb = (((size_t)b * 8 + hv) * 128) * 128 + sl * 16;
        __syncthreads();
#pragma unroll
        for (int e = 0; e < 8; ++e) sS[(kg8 + e) * 16 + col] = S[e];
        __syncthreads();
#pragma unroll
        for (int i = 0; i < 2; ++i) {
          int k = (tid >> 2) + 64 * i, c4 = (tid & 3) * 4;
          *(float4*)((p.out + oz) + O_GSS + gb + (size_t)k * 128 + c4) = *(const float4*)(sS + k * 16 + c4);
        }
        __syncthreads();
      }
    }
    __syncthreads();
  }
  if (isP) {
    const size_t sbase = (((size_t)b * 8 + hv) * 128 + kg8) * 128 + sl0 * 16 + col;
#pragma unroll
    for (int e = 0; e < 8; ++e) (p.out + oz)[O_GSP + sbase + (size_t)e * 128] = S[e];
  }
  __syncthreads();
}

__device__ __forceinline__ void gdn_chunk_item(const Params& p, int b, int hv, int sl4, char* smem) {
  const int oz = opaque_zero();
  bf16_t* sKb = (bf16_t*)smem;
  bf16_t* sQb = (bf16_t*)(smem + 4352);
  bf16_t* sKT = (bf16_t*)(smem + 8704);
  bf16_t* sSb = (bf16_t*)(smem + 18944);
  bf16_t* sVn = (bf16_t*)(smem + 27648);
  float* sKK = (float*)(smem + 30208);
  float* sQK = (float*)(smem + 31296);
  float* sKS = (float*)(smem + 32384);
  float* sQS = (float*)(smem + 34496);
  float* sL = (float*)(smem + 36608);
  float* sA = (float*)(smem + 37888);
  float* sVf = (float*)(smem + 38976);
  float* sG = (float*)(smem + 41024);
  float* sVnF = (float*)(smem + 41280);
  float* sG0 = (float*)(smem + 43392);

  const int tid = ((int)threadIdx.x + oz), lane = tid & 63, wave = tid >> 6;
  const bf16_t* QK = (const bf16_t*)((p.ws + oz) + GQK_OFF);
  const bf16_t* VV = (const bf16_t*)((p.ws + oz) + GVV_OFF);
  const float* SC = (const float*)((p.ws + oz) + GSC_OFF);
  bf16_t* rawo = (bf16_t*)((p.ws + oz) + R_OFF);
  const int hk = hv >> 1;
  const int row0 = b * 2048;
  const int ln = lane & 15, lg = lane >> 4;
  const int tok = tid >> 4, cc = (tid & 15) * 8;
  const int vtok = (tid & 63) >> 2, vpart = (tid & 3) * 8;
  const size_t ocol = (size_t)hv * 128 + sl4 * 32;

  for (int i = tid; i < 128 * 40; i += NTHREADS) sKT[i] = 0;
  for (int i = tid; i < 32 * 40; i += NTHREADS) sVn[i] = 0;

  f32x4v St[2][2];
#pragma unroll
  for (int e = 0; e < 4; ++e) { St[0][0][e] = 0.f; St[0][1][e] = 0.f; St[1][0][e] = 0.f; St[1][1][e] = 0.f; }

  struct PF { u32x4 pK, pQ, pV; float pg, pb; };
  PF R0, R1;
  auto prefetch = [&](PF& R, int t0) __attribute__((always_inline)) {
    const size_t r = (size_t)(row0 + t0 + tok) * 1024;
    R.pQ = *(const u32x4*)(QK + r + hk * 128 + cc);
    R.pK = *(const u32x4*)(QK + r + 512 + hk * 128 + cc);
    R.pV = *(const u32x4*)(VV + (size_t)(row0 + t0 + vtok) * 1024 + ocol + vpart);
    R.pg = SC[(size_t)(row0 + t0 + (tid & 15)) * 32 + 16 + hv]; R.pb = SC[(size_t)(row0 + t0 + (tid & 15)) * 32 + 8 + hv];
  };
  prefetch(R0, 0);
  prefetch(R1, 16);
  __syncthreads();
  float o_prev0 = 0.f, o_prev1 = 0.f;
  auto chunk_body = [&](PF& R, int t0) __attribute__((always_inline)) {
    *(u32x4*)(sKb + tok * 136 + cc) = R.pK;
    *(u32x4*)(sQb + tok * 136 + cc) = R.pQ;
    {
      float f[8];
      unpack8(R.pV, f);
      float* d = sVf + vtok * 32 + vpart;
      *(float4*)d = make_float4(f[0], f[1], f[2], f[3]); *(float4*)(d + 4) = make_float4(f[4], f[5], f[6], f[7]);
    }
    if (tid < 16) { sG0[tid * 2] = R.pg; sG0[tid * 2 + 1] = R.pb; }
#pragma unroll
    for (int tau = 0; tau < 2; ++tau)
#pragma unroll
      for (int nt = 0; nt < 2; ++nt) {
        u32x2 w; w.x = pack2(St[tau][nt][0], St[tau][nt][1]); w.y = pack2(St[tau][nt][2], St[tau][nt][3]);
        *(u32x2*)(sSb + (nt * 16 + ln) * 136 + wave * 32 + tau * 16 + lg * 4) = w;
      }
    __syncthreads();
    if (t0 > 0) {
      bf16_t* ro = rawo + (size_t)(row0 + t0 - 16 + (tid >> 4)) * 1024 + ocol + (tid & 15);
      ro[0] = f2bf(o_prev0); ro[16] = f2bf(o_prev1);
    }
    if (t0 + 32 < 2048) prefetch(R, t0 + 32);
    if (tid < 16) {
      const float gc = sG0[tid * 2], gl = sG0[15 * 2];
      sG[tid * 4] = gc; sG[tid * 4 + 1] = __expf(gc); sG[tid * 4 + 2] = sG0[tid * 2 + 1]; sG[tid * 4 + 3] = __expf(gl - gc);
    }
    {
      const bf16_t* Ab = (wave & 1) ? sQb : sKb;
      const bf16_t* Bb = (wave < 2) ? sKb : sSb;
      f32x4v acc0, acc1;
#pragma unroll
      for (int e = 0; e < 4; ++e) { acc0[e] = 0.f; acc1[e] = 0.f; }
#pragma unroll
      for (int st = 0; st < 4; ++st) {
        bf16x8_t af = *(const bf16x8_t*)(Ab + ln * 136 + st * 32 + lg * 8);
        bf16x8_t bf = *(const bf16x8_t*)(Bb + ln * 136 + st * 32 + lg * 8);
        acc0 = __builtin_amdgcn_mfma_f32_16x16x32_bf16(af, bf, acc0, 0, 0, 0);
        if (wave >= 2) {
          bf16x8_t bf1 = *(const bf16x8_t*)(sSb + (16 + ln) * 136 + st * 32 + lg * 8);
          acc1 = __builtin_amdgcn_mfma_f32_16x16x32_bf16(af, bf1, acc1, 0, 0, 0);
        }
      }
      if (wave < 2) {
        float* dst = (wave == 0) ? sKK : sQK;
#pragma unroll
        for (int r = 0; r < 4; ++r) dst[(lg * 4 + r) * 17 + ln] = acc0[r];
      } else {
        float* dst = (wave == 2) ? sKS : sQS;
#pragma unroll
        for (int r = 0; r < 4; ++r) { dst[(lg * 4 + r) * 33 + ln] = acc0[r]; dst[(lg * 4 + r) * 33 + 16 + ln] = acc1[r]; }
      }
    }
    __syncthreads();
    {
      const int i = tid >> 4, j = tid & 15;
      const float gci = sG[i * 4], gcj = sG[j * 4], bi = sG[i * 4 + 2], egi = sG[i * 4 + 1];
      const float dec = __expf(fminf(gci - gcj, 0.f));
      sL[j * 20 + i] = (i > j) ? bi * sKK[i * 17 + j] * dec : 0.f;
      sA[i * 17 + j] = (i >= j) ? sQK[i * 17 + j] * dec : 0.f;
      sVnF[i * 33 + j] = bi * (sVf[i * 32 + j] - egi * sKS[i * 33 + j]);
      sVnF[i * 33 + 16 + j] = bi * (sVf[i * 32 + 16 + j] - egi * sKS[i * 33 + 16 + j]);
    }
    __syncthreads();
    if (tid >= 64) {
      for (int pr = tid - 64; pr < 256; pr += 192) {
        const int k = pr >> 1, hb = (pr & 1) * 8;
        unsigned w[4];
#pragma unroll
        for (int e = 0; e < 4; ++e) {
          float a0 = bf2f(sKb[(hb + 2 * e) * 136 + k]) * sG[(hb + 2 * e) * 4 + 3];
          float a1 = bf2f(sKb[(hb + 2 * e + 1) * 136 + k]) * sG[(hb + 2 * e + 1) * 4 + 3];
          w[e] = pack2(a0, a1);
        }
        *(u32x4*)(sKT + k * 40 + hb) = mk_u4(w[0], w[1], w[2], w[3]);
      }
    }
    if (tid < 32) {
      f32x2 vn2[8];
#pragma unroll
      for (int q = 0; q < 8; ++q) { vn2[q].x = sVnF[(2 * q) * 33 + tid]; vn2[q].y = sVnF[(2 * q + 1) * 33 + tid]; }
#pragma unroll
      for (int j = 0; j < 15; ++j) {
        const float vj = (j & 1) ? vn2[j >> 1].y : vn2[j >> 1].x;
        f32x2 vj2; vj2.x = vj; vj2.y = vj;
        f32x2 lt2[8];
#pragma unroll
        for (int q4 = (j + 1) >> 2; q4 < 4; ++q4) {
          const f32x4 v4 = *(const f32x4*)(sL + j * 20 + q4 * 4);
          lt2[q4 * 2] = v4.xy; lt2[q4 * 2 + 1] = v4.zw;
        }
#pragma unroll
        for (int q = (j + 1) >> 1; q < 8; ++q) vn2[q] -= lt2[q] * vj2;
      }
#pragma unroll
      for (int q = 0; q < 8; ++q) {
        sVnF[(2 * q) * 33 + tid] = vn2[q].x; sVnF[(2 * q + 1) * 33 + tid] = vn2[q].y;
        *(unsigned*)(sVn + tid * 40 + 2 * q) = pack2(vn2[q].x, vn2[q].y);
      }
    }
    __syncthreads();
    {
      const int i = tid >> 4, n = tid & 15;
      const float eg = sG[i * 4 + 1];
      float o0 = eg * sQS[i * 33 + n], o1 = eg * sQS[i * 33 + 16 + n];
#pragma unroll
      for (int j = 0; j < 16; ++j) { const float a = sA[i * 17 + j]; o0 += a * sVnF[j * 33 + n]; o1 += a * sVnF[j * 33 + 16 + n]; }
      o_prev0 = o0; o_prev1 = o1;
    }
    {
      const float egl = __expf(sG[15 * 4]);
      const bf16x8_t bf0 = *(const bf16x8_t*)(sVn + ln * 40 + lg * 8);
      const bf16x8_t bf1 = *(const bf16x8_t*)(sVn + (16 + ln) * 40 + lg * 8);
#pragma unroll
      for (int tau = 0; tau < 2; ++tau) {
        const bf16x8_t af = *(const bf16x8_t*)(sKT + (wave * 32 + tau * 16 + ln) * 40 + lg * 8);
        f32x4v a0 = St[tau][0] * egl, a1 = St[tau][1] * egl;
        St[tau][0] = __builtin_amdgcn_mfma_f32_16x16x32_bf16(af, bf0, a0, 0, 0, 0);
        St[tau][1] = __builtin_amdgcn_mfma_f32_16x16x32_bf16(af, bf1, a1, 0, 0, 0);
      }
    }
  };
#pragma unroll 1
  for (int t0 = 0; t0 < 2048; t0 += 32) { chunk_body(R0, t0); chunk_body(R1, t0 + 16); }
  {
    bf16_t* ro = rawo + (size_t)(row0 + 2048 - 16 + (tid >> 4)) * 1024 + ocol + (tid & 15);
    ro[0] = f2bf(o_prev0); ro[16] = f2bf(o_prev1);
  }
#pragma unroll
  for (int tau = 0; tau < 2; ++tau)
#pragma unroll
    for (int nt = 0; nt < 2; ++nt)
#pragma unroll
      for (int r = 0; r < 4; ++r)
        (p.out + oz)[O_GSP + (((size_t)b * 8 + hv) * 128 + wave * 32 + tau * 16 + lg * 4 + r) * 128 + sl4 * 32 + nt * 16 + ln] = St[tau][nt][r];
  __syncthreads();
}

__device__ __forceinline__ void phase_gdn_scan(const Params& p, char* smem) {
  const int oz = opaque_zero();
  const int bid = ((int)blockIdx.x + oz), G = gridDim.x;
  if (G == 512) {
    if (bid < 256) {
      gdn_chunk_item(p, bid >> 5, (bid >> 2) & 7, bid & 3, smem);
    } else {
      for (int j = bid - 256; j < 1024; j += 256) gdn_item(p, MP + (j >> 3) * 4, 4, false, j >> 3, j & 7, 0, 8, smem);
    }
  } else {
    for (int it = bid; it < 256 + 1024; it += G) {
      if (it < 256) gdn_chunk_item(p, it >> 5, (it >> 2) & 7, it & 3, smem);
      else { const int j = it - 256; gdn_item(p, MP + (j >> 3) * 4, 4, false, j >> 3, j & 7, 0, 8, smem); }
    }
  }
}

__device__ __forceinline__ void phase_gdn_post(const Params& p) {
  const int oz = opaque_zero();
  const int lane = ((int)threadIdx.x + oz) & 63;
  const int gw = ((int)blockIdx.x + oz) * 4 + (((int)threadIdx.x + oz) >> 6), nw = gridDim.x * 4;
  bf16_t* U = (bf16_t*)((p.ws + oz) + U_OFF);
  const bf16_t* rawo = (const bf16_t*)((p.ws + oz) + R_OFF);
  const int ch = lane * 16;
  float ng[16];
#pragma unroll
  for (int e = 0; e < 16; ++e) ng[e] = (p.in[37] + oz)[(ch + e) & 127];
  for (int row = gw; row < MT; row += nw) {
    float y[16];
    unpack8(*(const u32x4*)(rawo + (size_t)row * 1024 + ch), y);
    unpack8(*(const u32x4*)(rawo + (size_t)row * 1024 + ch + 8), y + 8);
    float q2 = 0.f;
#pragma unroll
    for (int e = 0; e < 16; ++e) q2 += y[e] * y[e];
    q2 = sum8(q2);
    float rs = rsqrtf(q2 * (1.f / 128.f) + 1e-6f);
    bf16_t* u = U + (size_t)row * GD_LDU;
    float zf[16];
    unpack8(*(const u32x4*)(u + 2048 + ch), zf); unpack8(*(const u32x4*)(u + 2048 + ch + 8), zf + 8);
    unsigned w[8];
#pragma unroll
    for (int e = 0; e < 8; ++e) {
      float o0 = y[2 * e] * rs * ng[2 * e] * siluf(zf[2 * e]);
      float o1 = y[2 * e + 1] * rs * ng[2 * e + 1] * siluf(zf[2 * e + 1]);
      w[e] = pack2(o0, o1);
    }
    *(u32x4*)(u + ch) = mk_u4(w[0], w[1], w[2], w[3]);
    *(u32x4*)(u + ch + 8) = mk_u4(w[4], w[5], w[6], w[7]);
  }
}

__device__ __forceinline__ void phase_final_ln(const Params& p, const float* stats, const float* g, const float* bta) {
  const int oz = opaque_zero();
  const int lane = ((int)threadIdx.x + oz) & 63;
  const int gw = ((int)blockIdx.x + oz) * 4 + (((int)threadIdx.x + oz) >> 6), nw = gridDim.x * 4;
  float4 ggq[4], bbq[4];
#pragma unroll
  for (int q = 0; q < 4; ++q) { ggq[q] = *(const float4*)(g + (q * 64 + lane) * 4); bbq[q] = *(const float4*)(bta + (q * 64 + lane) * 4); }
  for (int r4 = gw * 4; r4 < MT; r4 += nw * 4) {
    float4 a[4][4];
    float mu[4], rs[4];
#pragma unroll
    for (int r = 0; r < 4; ++r) {
      const float4* z = (const float4*)((p.out + oz) + (size_t)(r4 + r) * 1024);
#pragma unroll
      for (int q = 0; q < 4; ++q) a[r][q] = z[q * 64 + lane];
      row_stats(stats, r4 + r, mu[r], rs[r]);
    }
#pragma unroll
    for (int q = 0; q < 4; ++q) {
      const float4 gg = ggq[q], bb = bbq[q];
#pragma unroll
      for (int r = 0; r < 4; ++r) {
        float4 v = a[r][q];
        v.x = (v.x - mu[r]) * rs[r] * gg.x + bb.x; v.y = (v.y - mu[r]) * rs[r] * gg.y + bb.y;
        v.z = (v.z - mu[r]) * rs[r] * gg.z + bb.z; v.w = (v.w - mu[r]) * rs[r] * gg.w + bb.w;
        ((float4*)((p.out + oz) + (size_t)(r4 + r) * 1024))[q * 64 + lane] = v;
      }
    }
  }
}

#define BAR_OFF ((size_t)255426560)
#define XB_TMO      128
#define XB_XCNT(j)  (256  + 64 * (j))
#define XB_XSUB(j)  (1280 + 64 * (j))
#define XB_XGEN(j)  (2304 + 64 * (j))
#define XB_TOP      3328
#define XB_TOPGEN   3392
#define XCD_BAR_WORDS 3456
#define XB_SPIN_CAP (1u << 20)
#define LAS __attribute__((address_space(3)))
__device__ __forceinline__ unsigned xb_ld(unsigned* p)              { return __hip_atomic_load(p, __ATOMIC_RELAXED, __HIP_MEMORY_SCOPE_AGENT); }
__device__ __forceinline__ unsigned xb_add(unsigned* p, unsigned v) { return __hip_atomic_fetch_add(p, v, __ATOMIC_RELAXED, __HIP_MEMORY_SCOPE_AGENT); }
__device__ __forceinline__ unsigned xb_xcc_id() { return (unsigned)__builtin_amdgcn_s_getreg((3 << 11) | 20) & 0xFu; }
#define XB_SPIN(cond, bar) do { unsigned _sp = 0; while (cond) { __builtin_amdgcn_s_sleep(1); \
    if ((++_sp & 255u) == 0u) { if (xb_ld(&(bar)[XB_TMO])) break; if (_sp > XB_SPIN_CAP) { atomicAdd(&(bar)[XB_TMO], 1u); break; } } } } while (0)
struct XcdBarrier { unsigned* bar; unsigned x; volatile LAS unsigned* st; };
__device__ __forceinline__ XcdBarrier xcd_barrier_post(unsigned* bar, volatile LAS unsigned* st) {
  XcdBarrier b; b.bar = bar; b.x = xb_xcc_id(); b.st = st;
  if (threadIdx.x == 0) (void)xb_add(&bar[XB_XCNT(b.x)], 1u);
  return b;
}
__device__ __forceinline__ void xcd_barrier_complete(unsigned* bar, unsigned x, unsigned& nloc, unsigned& nx) {
  const unsigned G = gridDim.x * gridDim.y * gridDim.z;
  unsigned sum, cnt, mine, sp = 0u;
  for (;;) {
    sum = 0u; cnt = 0u; mine = 0u;
#pragma unroll
    for (unsigned j = 0; j < 16; ++j) { const unsigned c = xb_ld(&bar[XB_XCNT(j)]); sum += c; cnt += (c > 0u) ? 1u : 0u; mine = (j == x) ? c : mine; }
    if (sum == G) break;
    __builtin_amdgcn_s_sleep(1);
    if ((++sp & 255u) == 0u) { if (xb_ld(&bar[XB_TMO])) break; if (sp > XB_SPIN_CAP) { atomicAdd(&bar[XB_TMO], 1u); break; } }
  }
  nloc = mine > 0u ? mine : 1u; nx = cnt > 0u ? cnt : 1u;
}
__device__ __forceinline__ void xcd_barrier(const XcdBarrier& b) {
  asm volatile("s_waitcnt vmcnt(0)" ::: "memory");
  __syncthreads();
  if (threadIdx.x == 0) {
    unsigned* bar = b.bar;
    __builtin_amdgcn_s_waitcnt(0);
    unsigned nloc = b.st[0], nx = b.st[1];
    if (nloc == 0u) { xcd_barrier_complete(bar, b.x, nloc, nx); b.st[0] = nloc; b.st[1] = nx; }
    const unsigned old = xb_add(&bar[XB_XSUB(b.x)], 1u);
    const unsigned gen = old / nloc;
    if (old + 1u == (gen + 1u) * nloc) {
      __builtin_amdgcn_fence(__ATOMIC_RELEASE, "agent");
      asm volatile("s_waitcnt vmcnt(0)" ::: "memory");
      const unsigned og = xb_add(&bar[XB_TOP], 1u);
      const unsigned tg = og / nx;
      if (og + 1u == (tg + 1u) * nx) xb_add(&bar[XB_TOPGEN], 1u);
      else XB_SPIN(xb_ld(&bar[XB_TOPGEN]) == tg, bar);
      __builtin_amdgcn_fence(__ATOMIC_ACQUIRE, "agent");
      xb_add(&bar[XB_XGEN(b.x)], 1u);
      asm volatile("s_waitcnt vmcnt(0)" ::: "memory");
    } else {
      XB_SPIN(xb_ld(&bar[XB_XGEN(b.x)]) == gen, bar);
      __builtin_amdgcn_fence(__ATOMIC_ACQUIRE, "agent");
      asm volatile("s_waitcnt vmcnt(0)" ::: "memory");
    }
  }
  __syncthreads();
}

#ifndef REP_SYNC
#define REP_SYNC 0
#endif
#ifndef REP_RWS
#define REP_RWS 1
#endif
#ifndef REP_GDS
#define REP_GDS 1
#endif
#ifndef REP_LRU
#define REP_LRU 1
#endif
#ifndef REP_G1
#define REP_G1 1
#endif
#ifndef NLAYERS
#define NLAYERS 4
#endif
#define GSYNC() xcd_barrier(xb)
__global__ void __launch_bounds__(NTHREADS, 2) fwd_megakernel(Params p) {
  cg::grid_group grid = cg::this_grid();
  int oz = opaque_zero();
  __shared__ u32x4 xb_words;
  if (threadIdx.x == 0) xb_words = mk_u4(0u, 0u, 0u, 0u);
  __syncthreads();
  XcdBarrier xb = xcd_barrier_post((unsigned*)(p.ws + BAR_OFF), (volatile LAS unsigned*)&xb_words);
  if (oz != 0) grid.sync();
  __shared__ __attribute__((aligned(16))) char smem[63488];
  const bf16_t* WT = (const bf16_t*)(p.ws + oz);
  bf16_t* U = (bf16_t*)((p.ws + oz) + U_OFF);
  bf16_t* A2r = (bf16_t*)((p.ws + oz) + R_OFF);
  float* stats0 = (float*)((p.ws + oz) + STATS_OFF);
  float* stats1 = (float*)((p.ws + oz) + STATS_OFF + STATS_SZ);
  const float* lng = (p.in[8] + oz); const float* lnb = (p.in[9] + oz);
  XSrc xnone{nullptr, nullptr, nullptr, nullptr, nullptr};

  phase_convert(p, smem);
  {
    XSrc x0s{p.in[0] + oz, p.in[1] + oz, nullptr, nullptr, nullptr};
    phase_prepass(p, x0s, false);
  }
  for (int rep = 0; rep < REP_SYNC; ++rep) GSYNC();
  GSYNC();

#pragma unroll 1
  for (int layer = 0; layer < NLAYERS; ++layer) {
    oz = opaque_zero();
    const int kind = layer == 3 ? 0 : layer;
    const int la = layer == 3 ? 1 : 0;
    XSrc xin;
    xin.p0 = layer == 0 ? (p.in[0] + oz) : (p.out + oz);
    xin.p1 = layer == 0 ? (p.in[1] + oz) : (p.out + oz) + (size_t)MP * DM;
    xin.stats = layer == 0 ? nullptr : ((layer & 1) ? stats0 : stats1);
    xin.g = lng + (layer == 0 ? 0 : (layer - 1) * 1024);
    xin.b = lnb + (layer == 0 ? 0 : (layer - 1) * 1024);
    float* stout = (layer & 1) ? stats1 : stats0;
    const bf16_t* Win = kind == 0 ? WT + W_LRUWIN(la) : (kind == 1 ? WT + W_RWWIN : WT + W_GDNWIN);
    const int NT1 = kind == 0 ? 16 : (kind == 1 ? 34 : 25);
    const int ldu = kind == 0 ? 2048 : (kind == 1 ? RW_LDU : GD_LDU);
    if (layer > 0) {
      phase_prepass(p, xin, kind == 1);
      GSYNC();
    }
    {
      const bf16_t* XA = (const bf16_t*)((p.ws + oz) + R_OFF);
      const bf16_t* XS = (const bf16_t*)((p.ws + oz) + XS_OFF);
      for (int rep = 0; rep < REP_G1; ++rep)
      if (kind == 1) gemm_phase<0, true>(XA, 1024, (p.in[19] + oz), XS, Win, 1024, NT1, U, ldu, xnone, nullptr, nullptr, smem);
      else gemm_phase<0, false>(XA, 1024, nullptr, nullptr, Win, 1024, NT1, U, ldu, xnone, nullptr, nullptr, smem);
    }
    GSYNC();
    if (kind == 0) {
      phase_lru_heavy(p, la, smem);
      GSYNC();
      phase_lru_carry(p, la);
      GSYNC();
      phase_lru_light(p);
      GSYNC();
    } else if (kind == 1) {
      phase_rwkv_pre(p, smem);
      GSYNC();
      phase_rwkv_scan(p, smem);
      GSYNC();
      phase_rwkv_post(p, xin);
      GSYNC();
    } else {
      phase_gdn_pre(p);
      GSYNC();
      phase_gdn_scan(p, smem);
      GSYNC();
      phase_gdn_post(p);
      GSYNC();
    }
    const bf16_t* A2 = kind == 0 ? A2r : U;
    const int lda2 = kind == 0 ? 1024 : ldu;
    const bf16_t* Wout = kind == 0 ? WT + W_LRUWOUT(la) : (kind == 1 ? WT + W_RWWOUT : WT + W_GDNWOUT);
    gemm_phase<1, false>(A2, lda2, nullptr, nullptr, Wout, 1024, 8, nullptr, 0, xin, (p.out + oz), stout, smem);
    GSYNC();
  }

  phase_final_ln(p, ((NLAYERS - 1) & 1) ? stats1 : stats0, lng + (NLAYERS - 1) * 1024, lnb + (NLAYERS - 1) * 1024);
}

extern "C" void kernel_launch(void* const* d_in, const int* in_sizes, int n_in, void* d_out, int out_size,
                              void* d_ws, size_t ws_size, hipStream_t stream) {
  static int grid_blocks = 0;
  if (!grid_blocks) {
    int dev = 0, cus = 0, per_cu = 0;
    hipGetDevice(&dev);
    hipDeviceGetAttribute(&cus, hipDeviceAttributeMultiprocessorCount, dev);
    hipOccupancyMaxActiveBlocksPerMultiprocessor(&per_cu, fwd_megakernel, NTHREADS, 0);
    if (per_cu < 1) per_cu = 1;
    if (per_cu > 2) per_cu = 2;
    grid_blocks = cus * per_cu;
  }
  Params p;
  memset(&p, 0, sizeof(p));
  for (int i = 0; i < 39; ++i) p.in[i] = (const float*)d_in[i];
  p.out = (float*)d_out;
  p.ws = (char*)d_ws;
  (void)hipMemsetAsync((char*)d_ws + BAR_OFF, 0, XCD_BAR_WORDS * sizeof(unsigned), stream);
  void* args[] = {&p};
  hipError_t e = hipLaunchCooperativeKernel((void*)fwd_megakernel, dim3(grid_blocks), dim3(NTHREADS), args, 0, stream);
  if (e != hipSuccess) fprintf(stderr, "cooperative launch failed: %s (grid %d)\n", hipGetErrorString(e), grid_blocks);
}
```
